# Optimizing an MI355X kernel written in HIP

```python
import jax, jax.numpy as jnp
from jax import lax
import numpy as np

D_MODEL = 4096
BATCH = 2
SEQ = 4096
DEPTH = 2

N_META = 16
MIX_W = D_MODEL
RET_W = MIX_W // 2
POOL_W = MIX_W - RET_W
RET_HEADS = 8
RET_HEAD_DIM = RET_W // RET_HEADS
CHUNK = 128
META_PAD = (-N_META) % CHUNK
POOL_WINDOWS = (2, 4, 8, 16)
N_POOL_GROUPS = len(POOL_WINDOWS)
POOL_GROUP = POOL_W // N_POOL_GROUPS
IN_COLS = 4 * RET_W + POOL_W
D_FF = ((8 * D_MODEL // 3 + 255) // 256) * 256
CONV_W = 3
ROPE_BASE = 10000.0
EPS = 1e-6

kernel_name = "hymba_retention_pool_convglu"


def rms_norm(x, g):
    xf = x.astype(jnp.float32)
    y = xf * lax.rsqrt(jnp.mean(xf * xf, axis=-1, keepdims=True) + EPS)
    return (y * g.astype(jnp.float32)).astype(x.dtype)


def rotary(x, pos):
    half = x.shape[-1] // 2
    inv = jnp.power(ROPE_BASE, -jnp.arange(half, dtype=jnp.float32) / half)
    ang = pos.astype(jnp.float32)[:, None] * inv[None, :]
    cos = jnp.cos(ang)[None, :, None, :]
    sin = jnp.sin(ang)[None, :, None, :]
    xf = x.astype(jnp.float32)
    x1, x2 = xf[..., :half], xf[..., half:]
    return jnp.concatenate([x1 * cos - x2 * sin, x1 * sin + x2 * cos], axis=-1).astype(x.dtype)


def retention(q, k, v):
    B, T, H, Dh = q.shape
    N = T // CHUNK
    f32 = jnp.float32
    log_gamma = jnp.log1p(-jnp.exp2(-5.0 - jnp.arange(H, dtype=f32)))
    idx = jnp.arange(CHUNK, dtype=f32)
    rel = idx[:, None] - idx[None, :]
    intra_decay = jnp.where(rel[None] >= 0,
                            jnp.exp(log_gamma[:, None, None] * jnp.maximum(rel, 0.0)[None]), 0.0)
    q_decay = jnp.exp(log_gamma[None, :] * (idx + 1.0)[:, None])
    k_decay = jnp.exp(log_gamma[None, :] * (CHUNK - 1.0 - idx)[:, None])
    chunk_decay = jnp.exp(log_gamma * CHUNK)

    qc = q.astype(f32).reshape(B, N, CHUNK, H, Dh)
    kc = k.astype(f32).reshape(B, N, CHUNK, H, Dh)
    vc = v.astype(f32).reshape(B, N, CHUNK, H, Dh)

    scores = jnp.einsum('bnchd,bnshd->bnhcs', qc, kc) * intra_decay[None, None]
    intra = jnp.einsum('bnhcs,bnshe->bnche', scores, vc)

    def step(state, xs):
        qn, kn, vn = xs
        cross = jnp.einsum('bchd,bhde->bche', qn * q_decay[None, :, :, None], state)
        state = state * chunk_decay[None, :, None, None] + jnp.einsum(
            'bchd,bche->bhde', kn * k_decay[None, :, :, None], vn)
        return state, cross

    state0 = jnp.zeros((B, H, Dh, Dh), f32)
    _, cross = lax.scan(step, state0, (jnp.moveaxis(qc, 1, 0), jnp.moveaxis(kc, 1, 0), jnp.moveaxis(vc, 1, 0)))
    cross = jnp.moveaxis(cross, 0, 1)
    return (intra + cross).reshape(B, T, H, Dh)


def multi_scale_pool(p, pool_w, pool_scale):
    B, L, _ = p.shape
    t = jnp.arange(L)
    outs = []
    for gi, w in enumerate(POOL_WINDOWS):
        xg = p[..., gi * POOL_GROUP:(gi + 1) * POOL_GROUP].astype(jnp.float32)
        cs = jnp.cumsum(xg, axis=1)
        cs_lag = jnp.pad(cs, ((0, 0), (w, 0), (0, 0)))[:, :L]
        cnt = jnp.minimum(t + 1, w).astype(jnp.float32)[None, :, None]
        mix = ((cs - cs_lag) / cnt - xg).astype(p.dtype)
        outs.append(jnp.einsum('blc,cd->bld', mix, pool_w[gi]))
    return jnp.concatenate(outs, axis=-1) * pool_scale


def hybrid_mixer(hn, w_in, pool_w, pool_scale, w_out, pos):
    B, L, _ = hn.shape
    proj = hn @ w_in
    q = proj[..., 0:RET_W].reshape(B, L, RET_HEADS, RET_HEAD_DIM)
    k = proj[..., RET_W:2 * RET_W].reshape(B, L, RET_HEADS, RET_HEAD_DIM)
    v = proj[..., 2 * RET_W:3 * RET_W].reshape(B, L, RET_HEADS, RET_HEAD_DIM)
    g = proj[..., 3 * RET_W:4 * RET_W]
    p = proj[..., 4 * RET_W:]

    q = rotary(q, pos)
    k = rotary(k, pos) * (RET_HEAD_DIM ** -0.5)
    pad = ((0, 0), (META_PAD, 0), (0, 0), (0, 0))
    r = retention(jnp.pad(q, pad), jnp.pad(k, pad), jnp.pad(v, pad))[:, META_PAD:]
    r = r * lax.rsqrt(jnp.mean(r * r, axis=-1, keepdims=True) + EPS)
    r = (r.reshape(B, L, RET_W) * jax.nn.silu(g.astype(jnp.float32))).astype(hn.dtype)

    m = multi_scale_pool(p, pool_w, pool_scale)

    return jnp.concatenate([r, m], axis=-1) @ w_out


def conv_glu_ffn(x, w_up, conv_w, conv_b, w_down):
    L = x.shape[1]
    u = x @ w_up
    a, b = u[..., :D_FF], u[..., D_FF:]
    ap = jnp.pad(a, ((0, 0), (CONV_W - 1, 0), (0, 0)))
    ac = conv_b
    for tap in range(CONV_W):
        ac = ac + ap[:, tap:tap + L] * conv_w[tap]
    return (jax.nn.silu(ac) * b) @ w_down


def setup_inputs(seed: int = 0) -> dict:
    key = jax.random.key(seed)
    ks = jax.random.split(key, 13)
    f32 = jnp.float32

    def nrm(k, shape, scale):
        return jax.random.normal(k, shape, f32) * scale

    return {
        "x": nrm(ks[0], (BATCH, SEQ, D_MODEL), 1.0),
        "meta_tokens": nrm(ks[1], (N_META, D_MODEL), 1.0),
        "norm1_g": 1.0 + nrm(ks[2], (DEPTH, D_MODEL), 0.02),
        "w_in": nrm(ks[3], (DEPTH, D_MODEL, IN_COLS), D_MODEL ** -0.5),
        "pool_w": nrm(ks[4], (DEPTH, N_POOL_GROUPS, POOL_GROUP, POOL_GROUP), POOL_GROUP ** -0.5),
        "pool_scale": 1.0 + nrm(ks[5], (DEPTH, POOL_W), 0.02),
        "w_out": nrm(ks[6], (DEPTH, MIX_W, D_MODEL), MIX_W ** -0.5),
        "norm2_g": 1.0 + nrm(ks[7], (DEPTH, D_MODEL), 0.02),
        "w_up": nrm(ks[8], (DEPTH, D_MODEL, 2 * D_FF), D_MODEL ** -0.5),
        "conv_w": nrm(ks[9], (DEPTH, CONV_W, D_FF), CONV_W ** -0.5),
        "conv_b": nrm(ks[10], (DEPTH, D_FF), 0.01),
        "w_down": nrm(ks[11], (DEPTH, D_FF, D_MODEL), D_FF ** -0.5),
        "final_g": 1.0 + nrm(ks[12], (D_MODEL,), 0.02),
    }


def reference(x, meta_tokens, norm1_g, w_in, pool_w, pool_scale, w_out, norm2_g, w_up, conv_w, conv_b, w_down, final_g):
    B = x.shape[0]
    meta = jnp.broadcast_to(meta_tokens[None].astype(x.dtype), (B, N_META, D_MODEL))
    h = jnp.concatenate([meta, x], axis=1)
    pos = jnp.arange(h.shape[1])
    for l in range(DEPTH):
        h = h + hybrid_mixer(rms_norm(h, norm1_g[l]), w_in[l], pool_w[l], pool_scale[l], w_out[l], pos)
        h = h + conv_glu_ffn(rms_norm(h, norm2_g[l]), w_up[l], conv_w[l], conv_b[l], w_down[l])
    return rms_norm(h, final_g)[:, N_META:]
```

```cpp
#include <hip/hip_runtime.h>
#include <cstdio>
#include <cstdint>

#define LAS __attribute__((address_space(3)))
#define GAS __attribute__((address_space(1)))
typedef unsigned short bf16_t;
typedef short bf16x8 __attribute__((ext_vector_type(8)));
typedef short bf16x4 __attribute__((ext_vector_type(4)));
typedef float f32x4 __attribute__((ext_vector_type(4)));
typedef unsigned u32x4 __attribute__((ext_vector_type(4)));
typedef unsigned u32x2 __attribute__((ext_vector_type(2)));

constexpr int D = 4096, NB = 2, SEQ = 4096, NMETA = 16;
constexpr int MMAIN = NB * SEQ;
constexpr int MP = 8448;
constexpr int METAR0 = 8432;
constexpr int NH = 8, DH = 256, RW = 2048, PW = 2048;
constexpr int INC = 10240, DFF = 11008, UPC = 22016;
constexpr int NLAYER = 2;
constexpr float EPS = 1e-6f;
constexpr int NCHK = 16;

constexpr size_t MiB = 1u << 20;
constexpr size_t WS_CTL = 0, CTL_ZERO_BYTES = 1 * MiB;
constexpr size_t WS_WIN = 1 * MiB;
constexpr size_t WS_WC = WS_WIN + 160 * MiB;
constexpr size_t WS_WB = WS_WC + 64 * MiB;
constexpr size_t WS_POOLS = WS_WB + 32 * MiB;
constexpr size_t WS_WUP = WS_POOLS + 4 * MiB;
constexpr size_t WS_WDN = WS_WUP + 344 * MiB;
constexpr size_t WS_H = WS_WDN + 172 * MiB;
constexpr size_t WS_HB = WS_H + 132 * MiB;
constexpr size_t WS_PROJ = WS_HB + 66 * MiB;
constexpr size_t WS_CAT = WS_PROJ + 165 * MiB;
constexpr size_t WS_KV = WS_CAT + 66 * MiB;
constexpr size_t WS_S = WS_KV + 64 * MiB;
constexpr size_t WS_U = WS_S + 32 * MiB;
constexpr size_t WS_G = WS_U + 355 * MiB;
constexpr size_t WS_SIDE = WS_G + 178 * MiB;
constexpr size_t WS_WDN8 = WS_SIDE + 10 * MiB;
constexpr size_t WS_END = WS_WDN8 + 44 * MiB;
constexpr int K1MIX = 7680;
constexpr size_t WS_WDN8L0 = WS_H;
constexpr int CW_TMO = 0;
constexpr int CW_BAR = 4096;
constexpr int CW_QCTR = 8192;
constexpr int CW_PCNT = 16384;
constexpr int CW_SS = 65536;
static_assert(CW_SS * 4 + 5 * MP * 8 <= (int)CTL_ZERO_BYTES, "ctl");

constexpr int RING_BYTES = 131072;
constexpr int MISC_OFF = RING_BYTES + 320;
constexpr int XCH_OFF = RING_BYTES + 1024;
constexpr int LDS_BYTES = 147456;
static_assert(XCH_OFF + 4096 <= LDS_BYTES, "lds");

__device__ __forceinline__ unsigned cvt_pk_bf16(float lo, float hi) { unsigned r; asm("v_cvt_pk_bf16_f32 %0, %1, %2" : "=v"(r) : "v"(lo), "v"(hi)); return r; }
__device__ __forceinline__ float bf_lo(unsigned w) { return __uint_as_float(w << 16); }
__device__ __forceinline__ float bf_hi(unsigned w) { return __uint_as_float(w & 0xffff0000u); }
__device__ __forceinline__ float fast_rcp(float x) { return __builtin_amdgcn_rcpf(x); }
__device__ __forceinline__ float silu_f(float x) { return x * fast_rcp(1.0f + __builtin_amdgcn_exp2f(-1.4426950408889634f * x)); }
__device__ __forceinline__ int posof(int R) { return R < MMAIN ? NMETA + (R & (SEQ - 1)) : (R >= METAR0 ? R - METAR0 : 0); }
__device__ __forceinline__ int prevrow(int R, int d) {
    if (R < MMAIN) { const int i = R & (SEQ - 1); return d <= i ? R - d : MP + (i - d); }
    return R - d;
}
__device__ __forceinline__ int lane_id_v() { int l; asm volatile("v_mbcnt_lo_u32_b32 %0, -1, 0\n\tv_mbcnt_hi_u32_b32 %0, -1, %0" : "=v"(l)); return l; }
__device__ __forceinline__ float shx(float x, int m) { return __builtin_bit_cast(float, __builtin_amdgcn_ds_bpermute((lane_id_v() ^ m) << 2, __builtin_bit_cast(int, x))); }
__device__ __forceinline__ float wave_sum(float v) {
#pragma unroll
    for (int o = 1; o < 64; o <<= 1) v += shx(v, o);
    return v;
}
__device__ __forceinline__ int launder_s(int v) { asm volatile("" : "+s"(v)); return v; }
typedef unsigned long long ssq_t;
constexpr float SSQ_SCALE = 1048576.0f, SSQ_INV = 1.0f / 1048576.0f;
__device__ __forceinline__ float rstd_of(const ssq_t* ss, int R) { return __builtin_amdgcn_rsqf((float)ss[R] * (SSQ_INV / D) + EPS); }
__device__ __forceinline__ void rstd8(const ssq_t* ss, int r0, float (&rs)[2][4]) {
    ssq_t q[8];
#pragma unroll
    for (int i = 0; i < 8; ++i) q[i] = ss[r0 + (i >> 2) * 128 + (i & 3) * 16];
    asm volatile("" : "+v"(q[0]), "+v"(q[1]), "+v"(q[2]), "+v"(q[3]), "+v"(q[4]), "+v"(q[5]), "+v"(q[6]), "+v"(q[7]));
#pragma unroll
    for (int i = 0; i < 8; ++i) rs[i >> 2][i & 3] = __builtin_amdgcn_rsqf((float)q[i] * (SSQ_INV / D) + EPS);
}
__device__ __forceinline__ void ssq_add(ssq_t* ss, int R, float sq) { __hip_atomic_fetch_add(ss + R, (ssq_t)(sq * SSQ_SCALE + 0.5f), __ATOMIC_RELAXED, __HIP_MEMORY_SCOPE_AGENT); }
__device__ __forceinline__ unsigned pk4_fp8(float a, float b, float c, float d) { int p = __builtin_amdgcn_cvt_pk_fp8_f32(a, b, 0, false); p = __builtin_amdgcn_cvt_pk_fp8_f32(c, d, p, true); return (unsigned)p; }
constexpr float W8_SCALE = 64.0f, W8_INV = 1.0f / 64.0f;
#define LDS_WAIT() asm volatile("s_waitcnt lgkmcnt(0)" ::: "memory")
#define VM_WAIT() asm volatile("s_waitcnt vmcnt(0)" ::: "memory")

__device__ __forceinline__ float head_lg(int h) { return log2f(1.0f - __builtin_amdgcn_exp2f(-5.0f - (float)h)); }
namespace pg8 {
constexpr int BM = 256, BK = 64, HALF = 128, HTB = HALF * BK * 2, STAGE_BYTES = 8 * HTB, NXCD = 8, WGM = 8;
__host__ __device__ __forceinline__ int lds_byte(int r, int c) { const int st = (r >> 4) * 2 + (c >> 5), rr = r & 15, cc = c & 31, ob = rr * 64 + cc * 2; return st * 1024 + (ob ^ (((ob >> 9) & 1) << 5)); }
__host__ __device__ __forceinline__ void stage_rc(int b, int& R, int& C) { const int st = b / 1024, sb = b % 1024, swz = sb ^ (((sb >> 9) & 1) << 5); R = (st >> 1) * 16 + swz / 64; C = (st & 1) * 32 + (swz % 64) / 2; }
__host__ __device__ __forceinline__ int perm32(int rho) { const int n = rho >> 4, i = rho & 15; return 8 * (i >> 2) + 4 * n + (i & 3); }

typedef int i32x8 __attribute__((ext_vector_type(8))); typedef int i32x4v __attribute__((ext_vector_type(4)));
__device__ __forceinline__ i32x8 pk8(bf16x8 lo, bf16x8 hi) { return __builtin_shufflevector(__builtin_bit_cast(i32x4v, lo), __builtin_bit_cast(i32x4v, hi), 0, 1, 2, 3, 4, 5, 6, 7); }
struct Unit { int pm, pn; };
struct Gemm { const bf16_t* A; const bf16_t* Bt; int M, N, K, lda, ldb; int agrp; unsigned agrp_bytes; int bgrp; unsigned bgrp_bytes; };

struct StaticOrder {
    int nM, nN, nwg, G, c;
    __host__ __device__ void init(int M, int N, int G_, int c_) { nM = M / BM; nN = N / BM; nwg = nM * nN; G = G_; c = c_; }
    __host__ __device__ bool next(int i, Unit& u) const {
        const long L = (long)i * G + c; if (L >= nwg) return false;
        int wgid = (int)L; { const int q = nwg / NXCD, r = nwg % NXCD, xcd = wgid % NXCD, off = wgid / NXCD; wgid = (xcd < r ? xcd * (q + 1) : r * (q + 1) + (xcd - r) * q) + off; }
        const int nig = WGM * nN, gid = wgid / nig, fm = gid * WGM, gsz = (nM - fm) < WGM ? (nM - fm) : WGM;
        u.pm = fm + ((wgid % nig) % gsz); u.pn = (wgid % nig) / gsz; return true;
    }
    __device__ __forceinline__ void a_ready(const Unit&) const {}
    __device__ __forceinline__ void done(const Unit&) const {}
};
struct RangeOrder {
    StaticOrder s; int i0, i1;
    __device__ __forceinline__ bool next(int i, Unit& u) const { return (i0 + i < i1) && s.next(i0 + i, u); }
    __device__ __forceinline__ void a_ready(const Unit&) const {}
    __device__ __forceinline__ void done(const Unit&) const {}
};
struct PanelOrder {
    int G, bx;
    __device__ __forceinline__ void init(int G_, int bx_) { G = G_; bx = bx_; }
    __device__ __forceinline__ bool next(int i, Unit& u) const {
        if (G == 256) { if (i >= 2) return false; const int x = bx & 7, k = bx >> 3; u.pm = 16 * i + 4 * (x >> 1) + (k & 3); u.pn = 8 * (x & 1) + (k >> 2); return true; }
        const int P = G / 16; if (P == 0 || bx >= 16 * P) return false;
        const int pm = i * P + bx / 16; if (i * P >= 32 || pm >= 32) return false;
        u.pm = pm; u.pn = bx % 16; return true;
    }
    __device__ __forceinline__ void a_ready(const Unit&) const {}
    __device__ __forceinline__ void done(const Unit&) const {}
};


struct EpiIn {
    static constexpr bool PERM = true, AFTER_DRAIN = false;
    bf16_t* proj; const ssq_t* ss;
    __device__ __forceinline__ void operator()(const f32x4 (&acc)[2][2][4][2], const Unit& u, int wr, int wc, int fr, int fq) const {
        const int row0 = u.pm * BM + wr * 64 + fr, kind = u.pn >> 3, colt = u.pn * BM + wc * 32 + 8 * fq;
        float invr[8];
#pragma unroll
        for (int e = 0; e < 8; ++e) invr[e] = __builtin_amdgcn_exp2f(-(float)(wc * 32 + 8 * fq + e) * (13.287712379549449f / 128.0f)) * 0.15915494309189535f;
        const float ksc = (kind == 1) ? 0.0625f : 1.0f;
        const float hlg = head_lg(u.pn & 7);
        float rsv[2][4]; rstd8(ss, row0, rsv);
#pragma unroll
        for (int ai = 0; ai < 2; ++ai)
#pragma unroll
            for (int m = 0; m < 4; ++m) {
                const int R = row0 + ai * HALF + m * 16;
                float rstd = rsv[ai][m];
                if (kind < 2) rstd *= __builtin_amdgcn_exp2f((kind == 0 ? 1.0f : -1.0f) * (float)(R & 255) * hlg);
                f32x4 v[2][2];
#pragma unroll
                for (int bj = 0; bj < 2; ++bj)
#pragma unroll
                    for (int n = 0; n < 2; ++n) v[bj][n] = acc[ai][bj][m][n] * rstd;
                if (kind < 2) {
                    const float t = (float)posof(R);
#pragma unroll
                    for (int n = 0; n < 2; ++n)
#pragma unroll
                        for (int j = 0; j < 4; ++j) {
                            const float f = __builtin_amdgcn_fractf(t * invr[4 * n + j]);
                            const float sn = __builtin_amdgcn_sinf(f), cs = __builtin_amdgcn_cosf(f);
                            const float x1 = v[0][n][j], x2 = v[1][n][j];
                            v[0][n][j] = (x1 * cs - x2 * sn) * ksc; v[1][n][j] = (x1 * sn + x2 * cs) * ksc;
                        }
                } else if (kind == 3) {
#pragma unroll
                    for (int bj = 0; bj < 2; ++bj)
#pragma unroll
                        for (int n = 0; n < 2; ++n)
#pragma unroll
                            for (int j = 0; j < 4; ++j) v[bj][n][j] = silu_f(v[bj][n][j]);
                }
                bf16_t* rowp = proj + (size_t)R * INC + colt;
#pragma unroll
                for (int bj = 0; bj < 2; ++bj) {
                    u32x4 w; w.x = cvt_pk_bf16(v[bj][0][0], v[bj][0][1]); w.y = cvt_pk_bf16(v[bj][0][2], v[bj][0][3]); w.z = cvt_pk_bf16(v[bj][1][0], v[bj][1][1]); w.w = cvt_pk_bf16(v[bj][1][2], v[bj][1][3]);
                    *(u32x4*)(rowp + bj * HALF) = w;
                }
            }
    }
};
struct EpiBf {
    static constexpr bool PERM = true, AFTER_DRAIN = false;
    bf16_t* O; int ldc; int coloff; const ssq_t* ss;
    __device__ __forceinline__ void operator()(const f32x4 (&acc)[2][2][4][2], const Unit& u, int wr, int wc, int fr, int fq) const {
        const int row0 = u.pm * BM + wr * 64 + fr, colt = coloff + u.pn * BM + wc * 32 + 8 * fq;
#pragma unroll
        for (int ai = 0; ai < 2; ++ai)
#pragma unroll
            for (int m = 0; m < 4; ++m) {
                const int R = row0 + ai * HALF + m * 16;
                const float rstd = ss ? rstd_of(ss, R) : 1.0f;
                bf16_t* rowp = O + (size_t)R * ldc + colt;
#pragma unroll
                for (int bj = 0; bj < 2; ++bj) {
                    const f32x4 v0 = acc[ai][bj][m][0] * rstd, v1 = acc[ai][bj][m][1] * rstd;
                    u32x4 w; w.x = cvt_pk_bf16(v0[0], v0[1]); w.y = cvt_pk_bf16(v0[2], v0[3]); w.z = cvt_pk_bf16(v1[0], v1[1]); w.w = cvt_pk_bf16(v1[2], v1[3]);
                    *(u32x4*)(rowp + bj * HALF) = w;
                }
            }
    }
};
struct EpiRes {
    static constexpr bool PERM = true, AFTER_DRAIN = false;
    const float* xsrc; bf16_t* hb; ssq_t* ssn; float sc;
    __device__ __forceinline__ void operator()(const f32x4 (&acc)[2][2][4][2], const Unit& u, int wr, int wc, int fr, int fq) const {
        const int row0 = u.pm * BM + wr * 64 + fr, colt = u.pn * BM + wc * 32 + 8 * fq;
        if (xsrc) {
#pragma unroll
            for (int ai = 0; ai < 2; ++ai) {
                f32x4 xv[4][2][2];
#pragma unroll
                for (int m = 0; m < 4; ++m)
#pragma unroll
                    for (int bj = 0; bj < 2; ++bj) { const float* sp = xsrc + (size_t)(row0 + ai * HALF + m * 16) * D + colt + bj * HALF; xv[m][bj][0] = *(const f32x4*)sp; xv[m][bj][1] = *(const f32x4*)(sp + 4); }
#pragma unroll
                for (int m = 0; m < 4; ++m) {
                    const int R = row0 + ai * HALF + m * 16;
                    float sq = 0.f;
#pragma unroll
                    for (int bj = 0; bj < 2; ++bj) {
                        const f32x4 a0 = xv[m][bj][0] + acc[ai][bj][m][0] * sc, a1 = xv[m][bj][1] + acc[ai][bj][m][1] * sc;
                        sq += (a0[0] * a0[0] + a0[1] * a0[1]) + (a0[2] * a0[2] + a0[3] * a0[3]) + (a1[0] * a1[0] + a1[1] * a1[1]) + (a1[2] * a1[2] + a1[3] * a1[3]);
                        u32x4 w; w.x = cvt_pk_bf16(a0[0], a0[1]); w.y = cvt_pk_bf16(a0[2], a0[3]); w.z = cvt_pk_bf16(a1[0], a1[1]); w.w = cvt_pk_bf16(a1[2], a1[3]);
                        *(u32x4*)(hb + (size_t)R * D + colt + bj * HALF) = w;
                    }
                    sq += shx(sq, 16); sq += shx(sq, 32);
                    if (fq == 0) ssq_add(ssn, R, sq);
                }
            }
        } else {
            u32x4 hv[2][4][2];
#pragma unroll
            for (int m = 0; m < 4; ++m)
#pragma unroll
                for (int bj = 0; bj < 2; ++bj) hv[0][m][bj] = *(const u32x4*)(hb + (size_t)(row0 + m * 16) * D + colt + bj * HALF);
#pragma unroll
            for (int m = 0; m < 2; ++m)
#pragma unroll
                for (int bj = 0; bj < 2; ++bj) hv[1][m][bj] = *(const u32x4*)(hb + (size_t)(row0 + HALF + m * 16) * D + colt + bj * HALF);
#pragma unroll
            for (int ai = 0; ai < 2; ++ai) {
                if (ai == 1) {
#pragma unroll
                    for (int m = 2; m < 4; ++m)
#pragma unroll
                        for (int bj = 0; bj < 2; ++bj) hv[1][m][bj] = *(const u32x4*)(hb + (size_t)(row0 + HALF + m * 16) * D + colt + bj * HALF);
                }
#pragma unroll
                for (int m = 0; m < 4; ++m) {
                    const int R = row0 + ai * HALF + m * 16;
                    float sq = 0.f;
#pragma unroll
                    for (int bj = 0; bj < 2; ++bj) {
                        const u32x4 h4 = hv[ai][m][bj];
                        f32x4 a0 = (f32x4){bf_lo(h4.x), bf_hi(h4.x), bf_lo(h4.y), bf_hi(h4.y)}, a1 = (f32x4){bf_lo(h4.z), bf_hi(h4.z), bf_lo(h4.w), bf_hi(h4.w)};
                        a0 += acc[ai][bj][m][0] * sc; a1 += acc[ai][bj][m][1] * sc;
                        sq += (a0[0] * a0[0] + a0[1] * a0[1]) + (a0[2] * a0[2] + a0[3] * a0[3]) + (a1[0] * a1[0] + a1[1] * a1[1]) + (a1[2] * a1[2] + a1[3] * a1[3]);
                        u32x4 w; w.x = cvt_pk_bf16(a0[0], a0[1]); w.y = cvt_pk_bf16(a0[2], a0[3]); w.z = cvt_pk_bf16(a1[0], a1[1]); w.w = cvt_pk_bf16(a1[2], a1[3]);
                        *(u32x4*)(hb + (size_t)R * D + colt + bj * HALF) = w;
                    }
                    sq += shx(sq, 16); sq += shx(sq, 32);
                    if (fq == 0) ssq_add(ssn, R, sq);
                }
            }
        }
    }
};

struct EpiFinal {
    static constexpr bool PERM = true, AFTER_DRAIN = false;
    const bf16_t* hb; ssq_t* ssn; float sc; unsigned* pcnt; const float* fg; float* out;
    __device__ __forceinline__ void operator()(f32x4 (&acc)[2][2][4][2], const Unit& u, int wr, int wc, int fr, int fq) const {
        const int row0 = u.pm * BM + wr * 64 + fr, colt = u.pn * BM + wc * 32 + 8 * fq;
        u32x4 hv[2][4][2];
#pragma unroll
        for (int ai = 0; ai < 2; ++ai)
#pragma unroll
            for (int m = 0; m < 4; ++m)
#pragma unroll
                for (int bj = 0; bj < 2; ++bj) hv[ai][m][bj] = *(const u32x4*)(hb + (size_t)(row0 + ai * HALF + m * 16) * D + colt + bj * HALF);
        f32x4 g4[2][2];
#pragma unroll
        for (int bj = 0; bj < 2; ++bj) { g4[bj][0] = *(const f32x4*)(fg + colt + bj * HALF); g4[bj][1] = *(const f32x4*)(fg + colt + bj * HALF + 4); }
#pragma unroll
        for (int ai = 0; ai < 2; ++ai)
#pragma unroll
            for (int m = 0; m < 4; ++m) {
                const int R = row0 + ai * HALF + m * 16;
                float sq = 0.f;
#pragma unroll
                for (int bj = 0; bj < 2; ++bj) {
                    const u32x4 h4 = hv[ai][m][bj];
                    f32x4 a0 = (f32x4){bf_lo(h4.x), bf_hi(h4.x), bf_lo(h4.y), bf_hi(h4.y)}, a1 = (f32x4){bf_lo(h4.z), bf_hi(h4.z), bf_lo(h4.w), bf_hi(h4.w)};
                    a0 += acc[ai][bj][m][0] * sc; a1 += acc[ai][bj][m][1] * sc;
                    sq += (a0[0] * a0[0] + a0[1] * a0[1]) + (a0[2] * a0[2] + a0[3] * a0[3]) + (a1[0] * a1[0] + a1[1] * a1[1]) + (a1[2] * a1[2] + a1[3] * a1[3]);
                    acc[ai][bj][m][0] = a0; acc[ai][bj][m][1] = a1;
                }
                sq += shx(sq, 16); sq += shx(sq, 32);
                if (fq == 0) ssq_add(ssn, R, sq);
            }
        asm volatile("s_waitcnt vmcnt(0)" ::: "memory");
        __builtin_amdgcn_s_barrier();
        if (wr == 0 && wc == 0 && lane_id_v() == 0) {
            unsigned* pc = pcnt + 16 * u.pm;
            __hip_atomic_fetch_add(pc, 1u, __ATOMIC_RELAXED, __HIP_MEMORY_SCOPE_AGENT);
            unsigned sp = 0;
            while (__hip_atomic_load(pc, __ATOMIC_RELAXED, __HIP_MEMORY_SCOPE_AGENT) < 16u) { __builtin_amdgcn_s_sleep(1); if (++sp > (1u << 22)) break; }
        }
        asm volatile("" ::: "memory");
        __builtin_amdgcn_s_barrier();
        asm volatile("" ::: "memory");
        ssq_t q[8];
#pragma unroll
        for (int i = 0; i < 8; ++i) q[i] = __hip_atomic_load(ssn + row0 + (i >> 2) * HALF + (i & 3) * 16, __ATOMIC_RELAXED, __HIP_MEMORY_SCOPE_AGENT);
        asm volatile("" : "+v"(q[0]), "+v"(q[1]), "+v"(q[2]), "+v"(q[3]), "+v"(q[4]), "+v"(q[5]), "+v"(q[6]), "+v"(q[7]));
#pragma unroll
        for (int ai = 0; ai < 2; ++ai)
#pragma unroll
            for (int m = 0; m < 4; ++m) {
                const int R = row0 + ai * HALF + m * 16;
                const float rstd = __builtin_amdgcn_rsqf((float)q[ai * 4 + m] * (SSQ_INV / D) + EPS);
#pragma unroll
                for (int bj = 0; bj < 2; ++bj) {
                    float* op = out + (size_t)R * D + colt + bj * HALF;
                    *(f32x4*)op = acc[ai][bj][m][0] * rstd * g4[bj][0]; *(f32x4*)(op + 4) = acc[ai][bj][m][1] * rstd * g4[bj][1];
                }
            }
    }
};


template <int N> __device__ __forceinline__ float ror16(float x) { return __builtin_bit_cast(float, __builtin_amdgcn_mov_dpp(__builtin_bit_cast(int, x), 0x120 | N, 0xf, 0xf, false)); }
template <int N> __device__ __forceinline__ f32x4 ror16v(f32x4 v) { return (f32x4){ror16<N>(v[0]), ror16<N>(v[1]), ror16<N>(v[2]), ror16<N>(v[3])}; }
struct EpiUpGlu {
    static constexpr bool PERM = true, AFTER_DRAIN = false;
    bf16_t* gact; const ssq_t* ss; const float* cw; const float* cb; float* side; LAS unsigned char* xl; int f8;
    __device__ __forceinline__ void operator()(const f32x4 (&acc)[2][2][4][2], const Unit& u, int wr, int wc, int fr, int fq) const {
        const int jc = u.pn * 128 + wc * 32 + 8 * fq, rowb = u.pm * BM + wr * 64;
        const bool f8u = f8 == 1 || (f8 == 2 && u.pn * 128 >= K1MIX);
        f32x4 w0[2], w1[2], w2[2], cbv[2];
#pragma unroll
        for (int n = 0; n < 2; ++n) { w0[n] = *(const f32x4*)(cw + jc + 4 * n); w1[n] = *(const f32x4*)(cw + DFF + jc + 4 * n); w2[n] = *(const f32x4*)(cw + 2 * DFF + jc + 4 * n); cbv[n] = *(const f32x4*)(cb + jc + 4 * n); }
        constexpr float NL2E = -1.4426950408889634f, NLN2 = -0.6931471805599453f;
#pragma unroll
        for (int n = 0; n < 2; ++n) { w0[n] *= NL2E; w1[n] *= NL2E; w2[n] *= NL2E; cbv[n] *= NL2E; }
        float rsv[2][4]; rstd8(ss, rowb + fr, rsv);
#pragma unroll
        for (int ai = 0; ai < 2; ++ai) {
            const float r3 = rsv[ai][3];
            if (fr >= 14) {
                LAS unsigned char* p = xl + ((((ai * 2 + wr) * 4 + wc) * 2 + (fr - 14)) * 128) + fq * 32;
                *(LAS f32x4*)p = acc[ai][0][3][0] * r3; *(LAS f32x4*)(p + 16) = acc[ai][0][3][1] * r3;
            }
        }
        asm volatile("s_waitcnt lgkmcnt(0)" ::: "memory"); __builtin_amdgcn_s_barrier(); asm volatile("" ::: "memory");
        float* SA = side; float* SB = side + 32 * 2 * DFF; float* SL = side + 2 * (32 * 2 * DFF);
#pragma unroll
        for (int ai = 0; ai < 2; ++ai) {
            const bool have_pred = (ai * 2 + wr) != 0;
            f32x4 B1[2], B2[2];
            { const LAS unsigned char* p = xl + (((((ai * 2 + wr) - 1) & 3) * 4 + wc) * 2) * 128 + fq * 32;
              B2[0] = *(const LAS f32x4*)p; B2[1] = *(const LAS f32x4*)(p + 16); B1[0] = *(const LAS f32x4*)(p + 128); B1[1] = *(const LAS f32x4*)(p + 144); }
            f32x4 gp[2] = {B1[0], B1[1]};
#pragma unroll
            for (int m = 0; m < 4; ++m) {
                const int R = rowb + ai * HALF + m * 16 + fr;
                const float rs = rsv[ai][m], rsn = rs * NLN2;
                f32x4 g[2], v[2], o[2];
#pragma unroll
                for (int n = 0; n < 2; ++n) { g[n] = acc[ai][0][m][n] * rs; v[n] = acc[ai][1][m][n] * rsn; }
#pragma unroll
                for (int n = 0; n < 2; ++n) {
                    f32x4 y1, y2;
                    if (m > 0) { y1 = fr == 15 ? gp[n] : g[n]; y2 = fr >= 14 ? gp[n] : g[n]; }
                    else { y1 = fr == 15 ? B1[n] : g[n]; y2 = fr == 15 ? B1[n] : (fr == 14 ? B2[n] : g[n]); }
                    const f32x4 p1 = ror16v<1>(y1), p2 = ror16v<2>(y2);
                    const f32x4 z = cbv[n] + p2 * w0[n] + p1 * w1[n] + g[n] * w2[n];
                    f32x4 q;
#pragma unroll
                    for (int j = 0; j < 4; ++j) q[j] = z[j] * __builtin_amdgcn_rcpf(1.0f + __builtin_amdgcn_exp2f(z[j]));
                    o[n] = q * v[n];
                }
                if (have_pred || m > 0 || fr >= 2) {
                    if (f8u) { u32x2 w8; w8.x = pk4_fp8(o[0][0], o[0][1], o[0][2], o[0][3]); w8.y = pk4_fp8(o[1][0], o[1][1], o[1][2], o[1][3]); __builtin_nontemporal_store(w8, (u32x2*)((unsigned char*)gact + (f8 == 1 ? (size_t)R * DFF + jc : (size_t)R * (2 * DFF) + K1MIX + jc))); }
                    else {
                    u32x4 w; w.x = cvt_pk_bf16(o[0][0], o[0][1]); w.y = cvt_pk_bf16(o[0][2], o[0][3]); w.z = cvt_pk_bf16(o[1][0], o[1][1]); w.w = cvt_pk_bf16(o[1][2], o[1][3]);
                    __builtin_nontemporal_store(w, (u32x4*)(gact + (size_t)R * DFF + jc)); }
                } else {
                    float* pa = SA + (size_t)(u.pm * 2 + fr) * DFF + jc; float* pb = SB + (size_t)(u.pm * 2 + fr) * DFF + jc;
                    *(f32x4*)pa = g[0]; *(f32x4*)(pa + 4) = g[1]; *(f32x4*)pb = acc[ai][1][m][0] * rs; *(f32x4*)(pb + 4) = acc[ai][1][m][1] * rs;
                }
                if (ai == 1 && wr == 1 && m == 3 && fr >= 14) { float* pl = SL + (size_t)(u.pm * 2 + (fr - 14)) * DFF + jc; *(f32x4*)pl = g[0]; *(f32x4*)(pl + 4) = g[1]; }
                gp[0] = g[0]; gp[1] = g[1];
            }
        }
    }
};
template <class Epi, class Sched, bool ALIGN_EPI = false, bool SP2 = false, bool F8 = false>
__device__ __forceinline__ void gemm_phase(LAS unsigned char* lds, const Gemm g, const Sched& S, const Epi& E, int wv) {
    wv = launder_s(wv);
    const int tid_l = wv * 64 + lane_id_v();
    const int tid = tid_l, wid = wv, lane = tid & 63, wr = wid >> 2, wc = wid & 3, fr = lane & 15, fq = lane >> 4;
    const int K = g.K, nt = K / BK;
    unsigned voffA[2], voffB[2];
#pragma unroll
    for (int i = 0; i < 2; ++i) { int R, C; stage_rc(tid * 16 + i * 8192, R, C); const int Rb = Epi::PERM ? ((R & ~31) + perm32(R & 31)) : R;
        voffA[i] = (unsigned)(R * g.lda + C) * 2u; voffB[i] = (unsigned)(Rb * g.ldb + C) * 2u; }
    const size_t kstep = (size_t)(BK * 2);
    const size_t hstepA = (size_t)HALF * g.lda * 2, hstepB = (size_t)HALF * g.ldb * 2;
    const size_t tstepA = 2 * hstepA, tstepB = 2 * hstepB;
    const unsigned ldsw = (unsigned)wid * 1024u, ldsbase = (unsigned)(size_t)lds;
    const int aoff = lds_byte(wr * 64 + fr, fq * 8), boff = lds_byte(wc * 32 + fr, fq * 8);
#define PG8_SA(b, h) (((b) * 2 + (h)) * HTB)
#define PG8_SB(b, h) ((4 + (b) * 2 + (h)) * HTB)
#define PG8_STAGE(bufoff, gbase, voff) do { _Pragma("unroll") for (int _i = 0; _i < 2; ++_i) \
        asm volatile("s_mov_b32 m0, %2\n\ts_nop 0\n\tglobal_load_lds_dwordx4 %0, %1" :: "v"((voff)[_i]), "s"((const char*)(gbase)), "s"(ldsbase + (unsigned)(bufoff) + ldsw + (unsigned)(_i * 8192)) : "memory", "m0"); } while (0)
#define PG8_LDA(dst, b, h) do { _Pragma("unroll") for (int m = 0; m < 4; ++m) _Pragma("unroll") for (int k = 0; k < 2; ++k) dst[m][k] = *(const LAS bf16x8*)(lds + PG8_SA(b, h) + aoff + m * 2048 + k * 1024); } while (0)
#define PG8_LDB(dst, b, h) do { _Pragma("unroll") for (int n = 0; n < 2; ++n) _Pragma("unroll") for (int k = 0; k < 2; ++k) dst[n][k] = *(const LAS bf16x8*)(lds + PG8_SB(b, h) + boff + n * 2048 + k * 1024); } while (0)
#define PG8_MMA(ai, bj, At, Bt) do { __builtin_amdgcn_s_setprio(1); _Pragma("unroll") for (int m = 0; m < 4; ++m) _Pragma("unroll") for (int n = 0; n < 2; ++n) { \
        if constexpr (F8) acc[ai][bj][m][n] = __builtin_amdgcn_mfma_scale_f32_16x16x128_f8f6f4(pk8(Bt[n][0], Bt[n][1]), pk8(At[m][0], At[m][1]), acc[ai][bj][m][n], 0, 0, 0, 0x7f7f7f7f, 0, 0x7f7f7f7f); \
        else { _Pragma("unroll") for (int k = 0; k < 2; ++k) acc[ai][bj][m][n] = __builtin_amdgcn_mfma_f32_16x16x32_bf16(Bt[n][k], At[m][k], acc[ai][bj][m][n], 0, 0, 0); } } __builtin_amdgcn_s_setprio(0); } while (0)
#define PG8_WAIT_V(n) asm volatile("s_waitcnt vmcnt(" #n ")" ::: "memory")
#define PG8_WAIT_L(n) asm volatile("s_waitcnt lgkmcnt(" #n ")" ::: "memory")
#define PG8_BAR __builtin_amdgcn_s_barrier()
#define PG8_SCHED __builtin_amdgcn_sched_barrier(0)
#define PG8_ABASE(u) ((const char*)g.A + (size_t)(u).pm * tstepA + (size_t)((u).pn / g.agrp) * g.agrp_bytes)
#define PG8_BBASE(u) ((const char*)g.Bt + (size_t)(u).pn * tstepB + (size_t)((u).pm / g.bgrp) * g.bgrp_bytes)
    Unit cur, nxt; int ui = 0;
    if (!S.next(0, cur)) return;
    f32x4 acc[2][2][4][2];
#pragma unroll
    for (int a = 0; a < 2; ++a)
#pragma unroll
        for (int b = 0; b < 2; ++b)
#pragma unroll
            for (int m = 0; m < 4; ++m)
#pragma unroll
                for (int n = 0; n < 2; ++n) acc[a][b][m][n] = (f32x4){0.f, 0.f, 0.f, 0.f};
    bf16x8 At[4][2], B0[2][2], B1[2][2];
    const char* cA = PG8_ABASE(cur); const char* cB = PG8_BBASE(cur);
    S.a_ready(cur);
    if constexpr (SP2) {
        PG8_STAGE(PG8_SB(0, 0), cB, voffB); PG8_STAGE(PG8_SB(0, 1), cB + hstepB, voffB); PG8_STAGE(PG8_SA(0, 0), cA, voffA); PG8_STAGE(PG8_SA(0, 1), cA + hstepA, voffA);
        if (wr == 1) PG8_BAR;
        PG8_WAIT_V(2); PG8_BAR;
        PG8_STAGE(PG8_SB(1, 0), cB + kstep, voffB); PG8_STAGE(PG8_SA(1, 0), cA + kstep, voffA); PG8_STAGE(PG8_SB(1, 1), cB + hstepB + kstep, voffB);
        PG8_WAIT_V(6); PG8_BAR;
    } else {
        PG8_STAGE(PG8_SB(0, 0), cB, voffB); PG8_STAGE(PG8_SA(0, 0), cA, voffA); PG8_STAGE(PG8_SB(0, 1), cB + hstepB, voffB); PG8_STAGE(PG8_SA(0, 1), cA + hstepA, voffA);
        if (wr == 1) PG8_BAR;
        PG8_WAIT_V(4); PG8_BAR;
        PG8_STAGE(PG8_SB(1, 0), cB + kstep, voffB); PG8_STAGE(PG8_SA(1, 0), cA + kstep, voffA); PG8_STAGE(PG8_SB(1, 1), cB + hstepB + kstep, voffB);
        PG8_WAIT_V(6); PG8_BAR;
    }
    for (;;) {
        const bool has_next = S.next(ui + 1, nxt);
        const char* nA = has_next ? PG8_ABASE(nxt) : cA; const char* nB = has_next ? PG8_BBASE(nxt) : cB;
        for (int t = 0; t < nt; t += 2) {
            const bool last = (t == nt - 2);
            const char* a1 = cA + (size_t)(t + 1) * kstep;
            const char* a2 = last ? nA : cA + (size_t)(t + 2) * kstep; const char* b2 = last ? nB : cB + (size_t)(t + 2) * kstep;
            const char* a3 = a2 + kstep; const char* b3 = b2 + kstep;
            if (last && has_next) S.a_ready(nxt);
            if constexpr (SP2) {
            PG8_LDB(B0, 0, 0); PG8_LDB(B1, 0, 1); PG8_SCHED; PG8_LDA(At, 0, 0); PG8_STAGE(PG8_SA(1, 1), a1 + hstepA, voffA);
            PG8_WAIT_V(8); PG8_WAIT_L(0); PG8_BAR; PG8_MMA(0, 0, At, B0); PG8_MMA(0, 1, At, B1); PG8_BAR; PG8_SCHED;
            PG8_LDA(At, 0, 1); PG8_STAGE(PG8_SB(0, 0), b2, voffB); PG8_STAGE(PG8_SB(0, 1), b2 + hstepB, voffB); PG8_STAGE(PG8_SA(0, 0), a2, voffA);
            PG8_WAIT_V(8); PG8_WAIT_L(0); PG8_BAR; PG8_MMA(1, 0, At, B0); PG8_MMA(1, 1, At, B1); PG8_BAR; PG8_SCHED;
            PG8_LDB(B0, 1, 0); PG8_LDB(B1, 1, 1); PG8_SCHED; PG8_LDA(At, 1, 0); PG8_STAGE(PG8_SA(0, 1), a2 + hstepA, voffA);
            PG8_WAIT_V(8); PG8_WAIT_L(0); PG8_BAR; PG8_MMA(0, 0, At, B0); PG8_MMA(0, 1, At, B1); PG8_BAR; PG8_SCHED;
            PG8_LDA(At, 1, 1); PG8_STAGE(PG8_SB(1, 0), b3, voffB); PG8_STAGE(PG8_SB(1, 1), b3 + hstepB, voffB); PG8_STAGE(PG8_SA(1, 0), a3, voffA);
            PG8_WAIT_V(8); PG8_WAIT_L(0); PG8_BAR; PG8_MMA(1, 0, At, B0); PG8_MMA(1, 1, At, B1); PG8_BAR; PG8_SCHED;
            } else {
            PG8_LDB(B0, 0, 0); PG8_SCHED; PG8_LDA(At, 0, 0); PG8_STAGE(PG8_SA(1, 1), a1 + hstepA, voffA);
            PG8_WAIT_L(8); PG8_BAR; PG8_WAIT_L(0); PG8_MMA(0, 0, At, B0); PG8_BAR; PG8_SCHED;
            PG8_LDB(B1, 0, 1); PG8_STAGE(PG8_SB(0, 0), b2, voffB);
            PG8_BAR; PG8_WAIT_L(0); PG8_MMA(0, 1, At, B1); PG8_BAR;
            PG8_LDA(At, 0, 1); PG8_STAGE(PG8_SA(0, 0), a2, voffA);
            PG8_BAR; PG8_WAIT_L(0); PG8_MMA(1, 0, At, B0); PG8_BAR; PG8_SCHED;
            PG8_STAGE(PG8_SB(0, 1), b2 + hstepB, voffB);
            PG8_WAIT_V(6); PG8_BAR; PG8_MMA(1, 1, At, B1); PG8_BAR;
            PG8_LDB(B0, 1, 0); PG8_SCHED; PG8_LDA(At, 1, 0); PG8_STAGE(PG8_SA(0, 1), a2 + hstepA, voffA);
            PG8_WAIT_L(8); PG8_BAR; PG8_WAIT_L(0); PG8_MMA(0, 0, At, B0); PG8_BAR; PG8_SCHED;
            PG8_LDB(B1, 1, 1); PG8_STAGE(PG8_SB(1, 0), b3, voffB);
            PG8_BAR; PG8_WAIT_L(0); PG8_MMA(0, 1, At, B1); PG8_BAR;
            PG8_LDA(At, 1, 1); PG8_STAGE(PG8_SA(1, 0), a3, voffA);
            PG8_BAR; PG8_WAIT_L(0); PG8_MMA(1, 0, At, B0); PG8_BAR; PG8_SCHED;
            PG8_STAGE(PG8_SB(1, 1), b3 + hstepB, voffB);
            PG8_WAIT_V(6); PG8_BAR; PG8_MMA(1, 1, At, B1); PG8_BAR;
            }
        }
        if constexpr (ALIGN_EPI) { if (wr == 0) PG8_BAR; }
        if constexpr (!Epi::AFTER_DRAIN) { const int tlx = lane_id_v(); const int frx = tlx & 15, fqx = (tlx >> 4) & 3;
            E(acc, cur, wr, wc, frx, fqx); S.done(cur); }
        if (!has_next) break;
#pragma unroll
        for (int a = 0; a < 2; ++a)
#pragma unroll
            for (int b = 0; b < 2; ++b)
#pragma unroll
                for (int m = 0; m < 4; ++m)
#pragma unroll
                    for (int n = 0; n < 2; ++n) acc[a][b][m][n] = (f32x4){0.f, 0.f, 0.f, 0.f};
        cur = nxt; cA = nA; cB = nB; ++ui;
        if constexpr (ALIGN_EPI) { if (wr == 1) PG8_BAR; }
    }
    PG8_WAIT_V(0);
    if constexpr (!ALIGN_EPI) { if (wr == 0) PG8_BAR; }
    PG8_BAR;
#undef PG8_SA
#undef PG8_SB
#undef PG8_STAGE
#undef PG8_LDA
#undef PG8_LDB
#undef PG8_MMA
#undef PG8_WAIT_V
#undef PG8_WAIT_L
#undef PG8_BAR
#undef PG8_SCHED
#undef PG8_ABASE
#undef PG8_BBASE
}

template <class Epi, class Sched>
__device__ __forceinline__ void gemm_phase_mix(LAS unsigned char* lds, const Gemm g, const char* A2, const char* B2, int nt2, const Sched& S, const Epi& E, int wv) {
    wv = launder_s(wv);
    const int tid_l = wv * 64 + lane_id_v();
    const int tid = tid_l, wid = wv, lane = tid & 63, wr = wid >> 2, wc = wid & 3, fr = lane & 15, fq = lane >> 4;
    const int nt1 = g.K / BK;
    unsigned voffA[2], voffB[2];
#pragma unroll
    for (int i = 0; i < 2; ++i) { int R, C; stage_rc(tid * 16 + i * 8192, R, C); const int Rb = Epi::PERM ? ((R & ~31) + perm32(R & 31)) : R;
        voffA[i] = (unsigned)(R * g.lda + C) * 2u; voffB[i] = (unsigned)(Rb * g.ldb + C) * 2u; }
    const size_t kstep = (size_t)(BK * 2);
    const size_t hA1 = (size_t)HALF * g.lda * 2, hB1 = (size_t)HALF * g.ldb * 2;
    const unsigned ldsw = (unsigned)wid * 1024u, ldsbase = (unsigned)(size_t)lds;
    const int aoff = lds_byte(wr * 64 + fr, fq * 8), boff = lds_byte(wc * 32 + fr, fq * 8);
#define PG8_SA(b, h) (((b) * 2 + (h)) * HTB)
#define PG8_SB(b, h) ((4 + (b) * 2 + (h)) * HTB)
#define PG8_STAGE(bufoff, gbase, voff) do { _Pragma("unroll") for (int _i = 0; _i < 2; ++_i) \
        asm volatile("s_mov_b32 m0, %2\n\ts_nop 0\n\tglobal_load_lds_dwordx4 %0, %1" :: "v"((voff)[_i]), "s"((const char*)(gbase)), "s"(ldsbase + (unsigned)(bufoff) + ldsw + (unsigned)(_i * 8192)) : "memory", "m0"); } while (0)
#define PG8_LDA(dst, b, h) do { _Pragma("unroll") for (int m = 0; m < 4; ++m) _Pragma("unroll") for (int k = 0; k < 2; ++k) dst[m][k] = *(const LAS bf16x8*)(lds + PG8_SA(b, h) + aoff + m * 2048 + k * 1024); } while (0)
#define PG8_LDB(dst, b, h) do { _Pragma("unroll") for (int n = 0; n < 2; ++n) _Pragma("unroll") for (int k = 0; k < 2; ++k) dst[n][k] = *(const LAS bf16x8*)(lds + PG8_SB(b, h) + boff + n * 2048 + k * 1024); } while (0)
#define PG8_MMA_BF(ai, bj, At, Bt) do { __builtin_amdgcn_s_setprio(1); _Pragma("unroll") for (int m = 0; m < 4; ++m) _Pragma("unroll") for (int n = 0; n < 2; ++n) { \
        _Pragma("unroll") for (int k = 0; k < 2; ++k) acc[ai][bj][m][n] = __builtin_amdgcn_mfma_f32_16x16x32_bf16(Bt[n][k], At[m][k], acc[ai][bj][m][n], 0, 0, 0); } __builtin_amdgcn_s_setprio(0); } while (0)
#define PG8_MMA_F8(ai, bj, At, Bt) do { __builtin_amdgcn_s_setprio(1); _Pragma("unroll") for (int m = 0; m < 4; ++m) _Pragma("unroll") for (int n = 0; n < 2; ++n) { \
        acc[ai][bj][m][n] = __builtin_amdgcn_mfma_scale_f32_16x16x128_f8f6f4(pk8(Bt[n][0], Bt[n][1]), pk8(At[m][0], At[m][1]), acc[ai][bj][m][n], 0, 0, 0, 0x7c7c7c7c, 0, 0x7c7c7c7c); } __builtin_amdgcn_s_setprio(0); } while (0)
#define PG8_WAIT_V(n) asm volatile("s_waitcnt vmcnt(" #n ")" ::: "memory")
#define PG8_WAIT_L(n) asm volatile("s_waitcnt lgkmcnt(" #n ")" ::: "memory")
#define PG8_BAR __builtin_amdgcn_s_barrier()
#define PG8_SCHED __builtin_amdgcn_sched_barrier(0)
#define PG8_ITER(MMA) do { \
            PG8_LDB(B0, 0, 0); PG8_LDB(B1, 0, 1); PG8_SCHED; PG8_LDA(At, 0, 0); PG8_STAGE(PG8_SA(1, 1), a1 + hA1, voffA); \
            PG8_WAIT_V(8); PG8_WAIT_L(0); PG8_BAR; MMA(0, 0, At, B0); MMA(0, 1, At, B1); PG8_BAR; PG8_SCHED; \
            PG8_LDA(At, 0, 1); PG8_STAGE(PG8_SB(0, 0), b2, voffB); PG8_STAGE(PG8_SB(0, 1), b2 + hB1, voffB); PG8_STAGE(PG8_SA(0, 0), a2, voffA); \
            PG8_WAIT_V(8); PG8_WAIT_L(0); PG8_BAR; MMA(1, 0, At, B0); MMA(1, 1, At, B1); PG8_BAR; PG8_SCHED; \
            PG8_LDB(B0, 1, 0); PG8_LDB(B1, 1, 1); PG8_SCHED; PG8_LDA(At, 1, 0); PG8_STAGE(PG8_SA(0, 1), a2 + hA1, voffA); \
            PG8_WAIT_V(8); PG8_WAIT_L(0); PG8_BAR; MMA(0, 0, At, B0); MMA(0, 1, At, B1); PG8_BAR; PG8_SCHED; \
            PG8_LDA(At, 1, 1); PG8_STAGE(PG8_SB(1, 0), b3, voffB); PG8_STAGE(PG8_SB(1, 1), b3 + hB1, voffB); PG8_STAGE(PG8_SA(1, 0), a3, voffA); \
            PG8_WAIT_V(8); PG8_WAIT_L(0); PG8_BAR; MMA(1, 0, At, B0); MMA(1, 1, At, B1); PG8_BAR; PG8_SCHED; } while (0)
    Unit cur, nxt; int ui = 0;
    if (!S.next(0, cur)) return;
    f32x4 acc[2][2][4][2];
#pragma unroll
    for (int a = 0; a < 2; ++a)
#pragma unroll
        for (int b = 0; b < 2; ++b)
#pragma unroll
            for (int m = 0; m < 4; ++m)
#pragma unroll
                for (int n = 0; n < 2; ++n) acc[a][b][m][n] = (f32x4){0.f, 0.f, 0.f, 0.f};
    bf16x8 At[4][2], B0[2][2], B1[2][2];
    const char* cA = (const char*)g.A + (size_t)cur.pm * (2 * hA1); const char* cB = (const char*)g.Bt + (size_t)cur.pn * (2 * hB1);
    PG8_STAGE(PG8_SB(0, 0), cB, voffB); PG8_STAGE(PG8_SB(0, 1), cB + hB1, voffB); PG8_STAGE(PG8_SA(0, 0), cA, voffA); PG8_STAGE(PG8_SA(0, 1), cA + hA1, voffA);
    if (wr == 1) PG8_BAR;
    PG8_WAIT_V(2); PG8_BAR;
    PG8_STAGE(PG8_SB(1, 0), cB + kstep, voffB); PG8_STAGE(PG8_SA(1, 0), cA + kstep, voffA); PG8_STAGE(PG8_SB(1, 1), cB + hB1 + kstep, voffB);
    PG8_WAIT_V(6); PG8_BAR;
    for (;;) {
        const bool has_next = S.next(ui + 1, nxt);
        const char* nA = has_next ? (const char*)g.A + (size_t)nxt.pm * (2 * hA1) : cA; const char* nB = has_next ? (const char*)g.Bt + (size_t)nxt.pn * (2 * hB1) : cB;
        const char* cA2 = A2 + (size_t)cur.pm * (2 * hA1); const char* cB2 = B2 + (size_t)cur.pn * (2 * hB1);
        for (int t = 0; t < nt1; t += 2) {
            const bool sw = (t == nt1 - 2);
            const char* a1 = cA + (size_t)(t + 1) * kstep;
            const char* a2 = sw ? cA2 : cA + (size_t)(t + 2) * kstep; const char* b2 = sw ? cB2 : cB + (size_t)(t + 2) * kstep;
            const char* a3 = a2 + kstep; const char* b3 = b2 + kstep;
            PG8_ITER(PG8_MMA_BF);
        }
        for (int t = 0; t < nt2; t += 2) {
            const bool sw = (t == nt2 - 2);
            const char* a1 = cA2 + (size_t)(t + 1) * kstep;
            const char* a2 = sw ? nA : cA2 + (size_t)(t + 2) * kstep; const char* b2 = sw ? nB : cB2 + (size_t)(t + 2) * kstep;
            const char* a3 = a2 + kstep; const char* b3 = b2 + kstep;
            PG8_ITER(PG8_MMA_F8);
        }
        if (wr == 0) PG8_BAR;
        { const int tlx = lane_id_v(); const int frx = tlx & 15, fqx = (tlx >> 4) & 3; E(acc, cur, wr, wc, frx, fqx); }
        if (!has_next) break;
#pragma unroll
        for (int a = 0; a < 2; ++a)
#pragma unroll
            for (int b = 0; b < 2; ++b)
#pragma unroll
                for (int m = 0; m < 4; ++m)
#pragma unroll
                    for (int n = 0; n < 2; ++n) acc[a][b][m][n] = (f32x4){0.f, 0.f, 0.f, 0.f};
        cur = nxt; cA = nA; cB = nB; ++ui;
        if (wr == 1) PG8_BAR;
    }
    PG8_WAIT_V(0);
    PG8_BAR;
    (void)fr; (void)fq;
#undef PG8_SA
#undef PG8_SB
#undef PG8_STAGE
#undef PG8_LDA
#undef PG8_LDB
#undef PG8_MMA_BF
#undef PG8_MMA_F8
#undef PG8_WAIT_V
#undef PG8_WAIT_L
#undef PG8_BAR
#undef PG8_SCHED
#undef PG8_ITER
}
}

#define XB_TMO      128
#define XB_XCNT(j)  (256  + 64 * (j))
#define XB_XSUB(j)  (1280 + 64 * (j))
#define XB_XGEN(j)  (2304 + 64 * (j))
#define XB_TOP      3328
#define XB_TOPGEN   3392
#define XCD_BAR_WORDS 3456
#define XB_SPIN_CAP (1u << 18)

__device__ __forceinline__ unsigned xb_ld(unsigned* p)              { return __hip_atomic_load(p, __ATOMIC_RELAXED, __HIP_MEMORY_SCOPE_AGENT); }
__device__ __forceinline__ unsigned xb_add(unsigned* p, unsigned v) { return __hip_atomic_fetch_add(p, v, __ATOMIC_RELAXED, __HIP_MEMORY_SCOPE_AGENT); }
__device__ __forceinline__ unsigned xb_xcc_id() { return (unsigned)__builtin_amdgcn_s_getreg((3 << 11) | 20) & 0xFu; }
#define XB_SPIN(cond, bar) do { unsigned _sp = 0; while (cond) { __builtin_amdgcn_s_sleep(1); \
    if ((++_sp & 255u) == 0u) { if (xb_ld(&(bar)[XB_TMO])) break; if (_sp > XB_SPIN_CAP) { atomicAdd(&(bar)[XB_TMO], 1u); break; } } } } while (0)

struct XcdBarrier {
    unsigned* bar; unsigned x;
    volatile LAS unsigned* st;
};
__device__ __forceinline__ XcdBarrier xcd_barrier_post(unsigned* bar, volatile LAS unsigned* st, int wave) {
    XcdBarrier b; b.bar = bar; b.x = xb_xcc_id(); b.st = st;
    if (wave == 0 && lane_id_v() == 0) (void)xb_add(&bar[XB_XCNT(b.x)], 1u);
    return b;
}
__device__ __forceinline__ void xcd_barrier_complete(unsigned* bar, unsigned x, unsigned& nloc, unsigned& nx) {
    const unsigned G = gridDim.x * gridDim.y * gridDim.z;
    unsigned sum, cnt, mine, sp = 0u;
    for (;;) {
        sum = 0u; cnt = 0u; mine = 0u;
#pragma unroll
        for (unsigned j = 0; j < 16; ++j) { const unsigned c = xb_ld(&bar[XB_XCNT(j)]); sum += c; cnt += (c > 0u) ? 1u : 0u; mine = (j == x) ? c : mine; }
        if (sum == G) break;
        __builtin_amdgcn_s_sleep(1);
        if ((++sp & 255u) == 0u) { if (xb_ld(&bar[XB_TMO])) break; if (sp > XB_SPIN_CAP) { atomicAdd(&bar[XB_TMO], 1u); break; } }
    }
    nloc = mine > 0u ? mine : 1u; nx = cnt > 0u ? cnt : 1u;
}
__device__ __forceinline__ void xcd_barrier(const XcdBarrier& b, int wave) {
    asm volatile("s_waitcnt vmcnt(0)" ::: "memory");
    __syncthreads();
    if (wave == 0 && lane_id_v() == 0) {
        unsigned* bar = b.bar; asm volatile("" : "+s"(bar));
        const unsigned bx = xb_xcc_id();
        __builtin_amdgcn_s_waitcnt(0);
        unsigned nloc = b.st[0], nx = b.st[1];
        if (nloc == 0u) { xcd_barrier_complete(bar, bx, nloc, nx); b.st[0] = nloc; b.st[1] = nx; }
        const unsigned old = xb_add(&bar[XB_XSUB(bx)], 1u);
        const unsigned gen = old / nloc;
        if (old + 1u == (gen + 1u) * nloc) {
            __builtin_amdgcn_fence(__ATOMIC_RELEASE, "agent");
            asm volatile("s_waitcnt vmcnt(0)" ::: "memory");
            const unsigned og = xb_add(&bar[XB_TOP], 1u);
            const unsigned tg = og / nx;
            if (og + 1u == (tg + 1u) * nx) xb_add(&bar[XB_TOPGEN], 1u);
            else XB_SPIN(xb_ld(&bar[XB_TOPGEN]) == tg, bar);
            __builtin_amdgcn_fence(__ATOMIC_ACQUIRE, "agent");
            xb_add(&bar[XB_XGEN(bx)], 1u);
            asm volatile("s_waitcnt vmcnt(0)" ::: "memory");
        } else {
            XB_SPIN(xb_ld(&bar[XB_XGEN(bx)]) == gen, bar);
            __builtin_amdgcn_fence(__ATOMIC_ACQUIRE, "agent");
            asm volatile("s_waitcnt vmcnt(0)" ::: "memory");
        }
    }
    __syncthreads();
}

constexpr int NWAVES = 8;
struct Frame {
    LAS unsigned char* lds;
    int tid, lane, wave, vcu, G;
};
#define FRESH(Fx) Frame Fx = F; { const int t_ = F.wave * 64 + lane_id_v(); Fx.tid = t_; Fx.lane = t_ & 63; }
struct Args {
    const float* x; const float* meta; const float* n1g; const float* w_in; const float* pool_w; const float* pool_scale; const float* w_out;
    const float* n2g; const float* w_up; const float* conv_w; const float* conv_b; const float* w_down; const float* final_g;
    float* out; unsigned char* ws; int ph_lo, ph_hi;
};
typedef const Args __attribute__((address_space(4))) CArgs;
__device__ __forceinline__ CArgs* args_ptr() { CArgs* p = (CArgs*)__builtin_amdgcn_kernarg_segment_ptr(); asm volatile("" : "+s"(p)); return p; }

constexpr int TP = 136;
__device__ __forceinline__ bf16x4 tr_read(const LAS unsigned char* p) { return __builtin_amdgcn_ds_read_tr16_b64_v4i16((LAS bf16x4*)p); }
struct TItem { const float* W; const float* ksc; bf16_t* WT; unsigned char* WT8; int ldw; unsigned ldo, ldo8; int k0, n0, nd0; int f8; };
__device__ __forceinline__ void t_load(const TItem& t, f32x4 (&v)[16], float (&ks)[16], int lane) {
    const int g = lane >> 4, i15 = lane & 15;
#pragma unroll
    for (int j = 0; j < 16; ++j) ks[j] = t.ksc ? t.ksc[t.k0 + 4 * j + g] : 1.0f;
#pragma unroll
    for (int j = 0; j < 16; ++j) v[j] = __builtin_nontemporal_load((const f32x4*)(t.W + (size_t)(t.k0 + 4 * j + g) * t.ldw + t.n0 + 4 * i15));
}
__device__ __forceinline__ void t_store(const TItem& t, const f32x4 (&v)[16], const float (&ks)[16], LAS unsigned char* scr, int lane) {
    const int g = lane >> 4, i15 = lane & 15;
#pragma unroll
    for (int j = 0; j < 16; ++j) {
        const float sc = ks[j];
        u32x2 w; w.x = cvt_pk_bf16(v[j][0] * sc, v[j][1] * sc); w.y = cvt_pk_bf16(v[j][2] * sc, v[j][3] * sc);
        *(LAS u32x2*)(scr + (4 * j + g) * TP + 8 * i15) = w;
    }
    LDS_WAIT(); asm volatile("" ::: "memory");
    const int qp = i15 >> 2, pp = lane & 3, Qa = 4 * g + pp, ca = Qa & 7, nqa = Qa >> 3;
    const int Qr = lane >> 2, cr = Qr & 7, nqr = Qr >> 3;
    const LAS unsigned char* ra = scr + (8 * ca + qp) * TP + 8 * nqa;
    bf16_t* wp = t.WT + (size_t)(t.nd0 + 4 * nqr + pp) * t.ldo + t.k0 + 8 * cr;
    if (t.f8) {
        unsigned char* wp8 = t.WT8 + (size_t)(t.nd0 + 4 * nqr + pp) * t.ldo8 + t.k0 + 8 * cr;
#pragma unroll
        for (int pass = 0; pass < 8; ++pass) {
            const u32x2 lo = __builtin_bit_cast(u32x2, tr_read(ra + 16 * pass)), hi = __builtin_bit_cast(u32x2, tr_read(ra + 4 * TP + 16 * pass));
            u32x2 o; o.x = pk4_fp8(bf_lo(lo.x) * W8_SCALE, bf_hi(lo.x) * W8_SCALE, bf_lo(lo.y) * W8_SCALE, bf_hi(lo.y) * W8_SCALE);
            o.y = pk4_fp8(bf_lo(hi.x) * W8_SCALE, bf_hi(hi.x) * W8_SCALE, bf_lo(hi.y) * W8_SCALE, bf_hi(hi.y) * W8_SCALE);
            __builtin_nontemporal_store(o, (u32x2*)(wp8 + (size_t)(8 * pass) * t.ldo8));
        }
    }
    if (t.f8 != 1) {
#pragma unroll
    for (int pass = 0; pass < 8; ++pass) {
        const bf16x4 lo = tr_read(ra + 16 * pass), hi = tr_read(ra + 4 * TP + 16 * pass);
        __builtin_nontemporal_store(__builtin_shufflevector(lo, hi, 0, 1, 2, 3, 4, 5, 6, 7), (bf16x8*)(wp + (size_t)(8 * pass) * t.ldo));
    }
    }
    LDS_WAIT(); asm volatile("" ::: "memory");
}
constexpr int T_IN = (D / 256) * (INC / 256), T_OT = (RW / 256) * (D / 256), T_UP = (D / 256) * (UPC / 256), T_DN = (DFF / 256) * (D / 256);
constexpr int T_LAYER = T_IN + 2 * T_OT + T_UP + T_DN;
__device__ __forceinline__ TItem t_decode(CArgs& a, int T, int w, int sub) {
    unsigned char* ws = a.ws; TItem t; t.f8 = 0; t.WT8 = nullptr; t.ldo8 = 0;
    int l = 0, kind = 0, r = T;
    if (r < T_IN) { kind = 0; }
    else if ((r -= T_IN) < 4 * T_OT) { l = r / (2 * T_OT); r -= l * 2 * T_OT; kind = 1; if (r >= T_OT) { kind = 2; r -= T_OT; } }
    else if ((r -= 4 * T_OT) < T_UP) { kind = 3; }
    else if ((r -= T_UP) < T_DN) { kind = 4; }
    else if ((r -= T_DN) < T_IN) { kind = 0; l = 1; }
    else if ((r -= T_IN) < T_UP) { kind = 3; l = 1; }
    else { r -= T_UP; kind = 4; l = 1; }
    const int kw = 128 * (w >> 2) + 64 * sub, nw = 64 * (w & 3);
    if (kind == 0) { const int nb = INC / 256; t.W = a.w_in + (size_t)l * D * INC; t.ldw = INC; t.ksc = a.n1g + l * D; t.WT = (bf16_t*)(ws + WS_WIN) + (size_t)l * INC * D; t.ldo = D; t.k0 = 256 * (r / nb) + kw; t.n0 = t.nd0 = 256 * (r % nb) + nw; return t; }
    if (kind == 1) { const int nb = D / 256; t.W = a.w_out + (size_t)l * D * D; t.ldw = D; t.ksc = nullptr; t.WT = (bf16_t*)(ws + WS_WC) + (size_t)l * D * D; t.ldo = D; t.k0 = 256 * (r / nb) + kw; t.n0 = t.nd0 = 256 * (r % nb) + nw; return t; }
    if (kind == 2) { const int nb = D / 256; t.W = a.w_out + (size_t)l * D * D + (size_t)RW * D; t.ldw = D; t.ksc = nullptr; t.WT = (bf16_t*)(ws + WS_WB) + (size_t)l * D * PW; t.ldo = PW; t.k0 = 256 * (r / nb) + kw; t.n0 = t.nd0 = 256 * (r % nb) + nw; return t; }
    if (kind == 3) { const int nb = UPC / 256, n0 = 256 * (r % nb) + nw, nn = n0 < DFF ? n0 : n0 - DFF;
        t.W = a.w_up + (size_t)l * D * UPC; t.ldw = UPC; t.ksc = a.n2g + l * D; t.WT = (bf16_t*)(ws + WS_WUP) + (size_t)l * UPC * D; t.ldo = D; t.k0 = 256 * (r / nb) + kw; t.n0 = n0; t.nd0 = 256 * (nn / 128) + (nn % 128) + (n0 < DFF ? 0 : 128); return t; }
    { const int nb = D / 256; t.W = a.w_down + (size_t)l * DFF * D; t.ldw = D; t.ksc = nullptr; t.WT = (bf16_t*)(ws + WS_WDN) + (size_t)l * D * DFF; t.ldo = DFF;
      if (l == NLAYER - 1) { t.f8 = 1; t.WT8 = ws + WS_WDN8; t.ldo8 = DFF; }
      else if (256 * (r / nb) >= K1MIX) { t.f8 = 2; t.WT8 = ws + WS_WDN8L0; t.ldo8 = 2 * DFF; }
      t.k0 = 256 * (r / nb) + kw; t.n0 = t.nd0 = 256 * (r % nb) + nw; return t; }
}
constexpr int T_EARLY = T_IN + 4 * T_OT, T_L0 = T_EARLY + T_UP + T_DN, T_ALL = NLAYER * T_LAYER;
__device__ __forceinline__ void conv_tiles(const Frame& F0, CArgs& a, int j0, int j1) {
    Frame F = F0; { const int t_ = F0.wave * 64 + lane_id_v(); F.tid = t_; F.lane = t_ & 63; }
    LAS unsigned char* scr = F.lds + F.wave * 16384;
    {
        int T = j0 + F.vcu, sub = 0;
        if (T < j1) {
            TItem cur = t_decode(a, T, F.wave, 0); f32x4 va[16], vb[16]; float ka[16], kb[16];
            t_load(cur, va, ka, F.lane);
            for (;;) {
                const int Tn = sub ? T + F.G : T, subn = sub ^ 1; const bool more = Tn < j1;
                TItem nxt = cur; if (more) { nxt = t_decode(a, Tn, F.wave, subn); t_load(nxt, vb, kb, F.lane); }
                t_store(cur, va, ka, scr, F.lane);
                if (!more) break;
#pragma unroll
                for (int j = 0; j < 16; ++j) { va[j] = vb[j]; ka[j] = kb[j]; }
                cur = nxt; T = Tn; sub = subn;
            }
        }
    }
    __syncthreads();
}
__device__ __forceinline__ void pools_build(const Frame& F, CArgs& a) {
    unsigned char* ws = a.ws;
    {
        const int gt = F.vcu * (NWAVES * 64) + F.wave * 64 + lane_id_v(), NT = F.G * NWAVES * 64;
        bf16_t* ps = (bf16_t*)(ws + WS_POOLS);
        for (int i = gt; i < NLAYER * 2048 * 512 / 8; i += NT) {
            const int e = i * 8, l = e / (2048 * 512), rem = e % (2048 * 512), g = rem / (512 * 512), d = rem % 512;
            const f32x4 w0 = *(const f32x4*)(a.pool_w + e), w1 = *(const f32x4*)(a.pool_w + e + 4);
            const f32x4 s0 = *(const f32x4*)(a.pool_scale + l * PW + g * 512 + d), s1 = *(const f32x4*)(a.pool_scale + l * PW + g * 512 + d + 4);
            u32x4 o; o.x = cvt_pk_bf16(w0[0] * s0[0], w0[1] * s0[1]); o.y = cvt_pk_bf16(w0[2] * s0[2], w0[3] * s0[3]); o.z = cvt_pk_bf16(w1[0] * s1[0], w1[1] * s1[1]); o.w = cvt_pk_bf16(w1[2] * s1[2], w1[3] * s1[3]);
            *(u32x4*)(ps + e) = o;
        }
    }
}
__device__ __forceinline__ void p0_prologue(Frame& F0, CArgs& a) {
    Frame F = F0; { const int t_ = F0.wave * 64 + lane_id_v(); F.tid = t_; F.lane = t_ & 63; }
    const int gw = F.vcu * NWAVES + F.wave, NGW = F.G * NWAVES;
    unsigned char* ws = a.ws;
    conv_tiles(F0, a, 0, T_IN);
    {
        bf16_t* hb = (bf16_t*)(ws + WS_HB); ssq_t* ss0 = (ssq_t*)((unsigned*)(ws + WS_CTL) + CW_SS);
        int r0, nr, st;
        if (F.G == 256) { const bool lowc = F.vcu < 128; const int nrow = lowc ? 25 : 41; r0 = (lowc ? F.vcu * 25 : 3200 + (F.vcu - 128) * 41) + F.wave; st = 8; nr = (nrow - F.wave + 7) / 8; }
        else { r0 = gw; st = NGW; nr = (MP - gw + NGW - 1) / NGW; }
        for (int k_ = 0; k_ < nr; ++k_) { const int R = r0 + st * k_;
            const float* src = R < MMAIN ? a.x + (size_t)R * D : (R >= METAR0 ? a.meta + (size_t)(R - METAR0) * D : nullptr);
            float s = 0.f;
            f32x4 xv[16];
#pragma unroll
            for (int j = 0; j < 16; ++j) xv[j] = *(const f32x4*)((src ? src : a.x) + 4 * F.lane + 256 * j);
            asm volatile("" : "+v"(xv[0]), "+v"(xv[1]), "+v"(xv[2]), "+v"(xv[3]), "+v"(xv[4]), "+v"(xv[5]), "+v"(xv[6]), "+v"(xv[7]), "+v"(xv[8]), "+v"(xv[9]), "+v"(xv[10]), "+v"(xv[11]), "+v"(xv[12]), "+v"(xv[13]), "+v"(xv[14]), "+v"(xv[15]));
#pragma unroll
            for (int j = 0; j < 16; ++j) {
                f32x4 v = xv[j]; if (!src) v = (f32x4){0.f, 0.f, 0.f, 0.f};
                s += (v[0] * v[0] + v[1] * v[1]) + (v[2] * v[2] + v[3] * v[3]);
                u32x2 w; w.x = cvt_pk_bf16(v[0], v[1]); w.y = cvt_pk_bf16(v[2], v[3]);
                *(u32x2*)(hb + (size_t)R * D + 4 * F.lane + 256 * j) = w;
            }
            s = wave_sum(s);
            if (F.lane == 0) ss0[R] = (ssq_t)(s * SSQ_SCALE + 0.5f);
        }
    }
}

constexpr int RSLOT = 32768;
#define RT_WAIT_V(n) asm volatile("s_waitcnt vmcnt(" #n ")" ::: "memory")
__device__ __forceinline__ unsigned lds_addr(const LAS void* p) { return (unsigned)(size_t)p; }
__device__ __forceinline__ void glds16(const void* gsrc, unsigned lds_dst) {
    unsigned keep;
    asm volatile("s_mov_b32 %0, m0\n\ts_mov_b32 m0, %2\n\ts_nop 0\n\tglobal_load_lds_dwordx4 %1, off\n\ts_mov_b32 m0, %0" : "=&s"(keep) : "v"(gsrc), "s"(lds_dst) : "memory");
}
#define RT_BAR() do { asm volatile("s_waitcnt lgkmcnt(0)\n\ts_barrier" ::: "memory"); } while (0)
__device__ __forceinline__ bf16x8 cat4(bf16x4 a, bf16x4 b) { return __builtin_shufflevector(a, b, 0, 1, 2, 3, 4, 5, 6, 7); }

__device__ __forceinline__ void kv_unit(Frame& F, const bf16_t* proj, float* outp, int base_row, int h) {
    const int tid_l = F.wave * 64 + lane_id_v();
    const int tid = tid_l, lane = tid_l & 63, w = F.wave, wd = w >> 1, we = w & 1, g = lane >> 4, q = (lane & 15) >> 2, p = lane & 3;
    const float lg = head_lg(h), c255 = __builtin_amdgcn_exp2f(255.0f * lg);
    const bf16_t* Kp = proj + (size_t)base_row * INC + RW + h * DH;
    const bf16_t* Vp = proj + (size_t)base_row * INC + 2 * RW + h * DH;
    unsigned soff[2];
#pragma unroll
    for (int i = 0; i < 2; ++i) { const int id = tid + 512 * i, row = id >> 5, sc = id & 31; soff[i] = (unsigned)(row * INC + 8 * (sc ^ (2 * (row & 7)))) * 2u; }
    const unsigned ring = __builtin_amdgcn_readfirstlane(lds_addr(F.lds) + (unsigned)w * 1024u);
#define KV_ISSUE(cb) do { const unsigned sl_ = ring + (unsigned)((cb) & 3) * RSLOT; const char* kp_ = (const char*)(Kp + (size_t)(32 * (cb)) * INC); const char* vp_ = (const char*)(Vp + (size_t)(32 * (cb)) * INC); \
        glds16(kp_ + soff[0], sl_); glds16(kp_ + soff[1], sl_ + 8192); glds16(vp_ + soff[0], sl_ + 16384); glds16(vp_ + soff[1], sl_ + 16384 + 8192); } while (0)
    const int rr = 4 * g + q, swz0 = 2 * (rr & 7), ph = p >> 1;
    const unsigned rbase = (unsigned)(rr * 512 + 8 * (p & 1));
    f32x4 acc[4][8];
#pragma unroll
    for (int i = 0; i < 4; ++i)
#pragma unroll
        for (int j = 0; j < 8; ++j) acc[i][j] = (f32x4){0.f, 0.f, 0.f, 0.f};
    KV_ISSUE(0); KV_ISSUE(1); KV_ISSUE(2);
    for (int cb = 0; cb < 8; ++cb) {
        if (cb + 2 < 8) RT_WAIT_V(8); else if (cb + 1 < 8) RT_WAIT_V(4); else RT_WAIT_V(0);
        RT_BAR();
        if (cb + 3 < 8) KV_ISSUE(cb + 3);
        int swz = swz0; asm volatile("" : "+v"(swz));
        const LAS unsigned char* kb = F.lds + (cb & 3) * RSLOT; const LAS unsigned char* vb = kb + 16384;
        bf16x8 af[4], bfr[8];
#pragma unroll
        for (int dt = 0; dt < 4; ++dt) {
            const unsigned co = (unsigned)((((2 * (4 * wd + dt)) ^ swz) | ph) * 16);
            const bf16x4 lo = tr_read(kb + rbase + co), hi = tr_read(kb + rbase + 16 * 512 + co);
            af[dt] = cat4(lo, hi);
        }
#pragma unroll
        for (int et = 0; et < 8; ++et) {
            const unsigned co = (unsigned)((((2 * (8 * we + et)) ^ swz) | ph) * 16);
            bfr[et] = cat4(tr_read(vb + rbase + co), tr_read(vb + rbase + 16 * 512 + co));
        }
#pragma unroll
        for (int dt = 0; dt < 4; ++dt)
#pragma unroll
            for (int et = 0; et < 8; ++et) acc[dt][et] = __builtin_amdgcn_mfma_f32_16x16x32_bf16(af[dt], bfr[et], acc[dt][et], 0, 0, 0);
    }
#undef KV_ISSUE
#pragma unroll
    for (int dt = 0; dt < 4; ++dt)
#pragma unroll
        for (int et = 0; et < 8; ++et) *(f32x4*)(outp + (size_t)(16 * (8 * we + et) + (lane & 15)) * DH + 16 * (4 * wd + dt) + 4 * g) = acc[dt][et] * c255;
    asm volatile("s_waitcnt lgkmcnt(0)" ::: "memory"); RT_BAR();
}

__device__ __forceinline__ void ret_unit(Frame& F, const bf16_t* proj, const bf16_t* St, bf16_t* cat, int base_row, int h, int half, bool has_state, int sb0) {
    const int tid_l = F.wave * 64 + lane_id_v();
    const int tid = tid_l, lane = tid_l & 63, w = F.wave, g = lane >> 4, fr = lane & 15, q = fr >> 2, p = lane & 3;
    const float lg = head_lg(h);
    const int c0 = 128 * half + 16 * w, cl = c0 + fr, R = base_row + cl;
    const bf16_t* Kp = proj + (size_t)base_row * INC + RW + h * DH;
    const bf16_t* Vp = proj + (size_t)base_row * INC + 2 * RW + h * DH;
    bf16x8 qf[8];
#pragma unroll
    for (int ks = 0; ks < 8; ++ks) qf[ks] = *(const bf16x8*)(proj + (size_t)R * INC + h * DH + 32 * ks + 8 * g);
    f32x4 acc[16];
#pragma unroll
    for (int i = 0; i < 16; ++i) acc[i] = (f32x4){0.f, 0.f, 0.f, 0.f};
    const int nst = has_state ? 8 : 0, nsb = 4 * half + 4;
    const int my_sb_max = (c0 + 15) >> 5;
    unsigned soS[2], soK[2], soV[2];
#pragma unroll
    for (int i = 0; i < 2; ++i) { const int id = tid + 512 * i; soS[i] = (unsigned)((id >> 2) * DH + 8 * (id & 3)) * 2u;
        const int row = id >> 5, sc = id & 31; soK[i] = (unsigned)(row * INC + 8 * (sc ^ (row & 15))) * 2u; soV[i] = (unsigned)(row * INC + 8 * (sc ^ (2 * (row & 7)))) * 2u; }
    const unsigned ring = __builtin_amdgcn_readfirstlane(lds_addr(F.lds) + (unsigned)w * 1024u);
#define RT_ISSUE_S(s) do { const unsigned sl_ = ring + (unsigned)((s) % 3) * RSLOT; const char* sp_ = (const char*)(St + 32 * (s)); glds16(sp_ + soS[0], sl_); glds16(sp_ + soS[1], sl_ + 8192); } while (0)
#define RT_ISSUE_KV(s, sb) do { const unsigned sl_ = ring + (unsigned)((s) % 3) * RSLOT; const char* kp_ = (const char*)(Kp + (size_t)(32 * (sb)) * INC); const char* vp_ = (const char*)(Vp + (size_t)(32 * (sb)) * INC); \
        glds16(kp_ + soK[0], sl_); glds16(kp_ + soK[1], sl_ + 8192); glds16(vp_ + soV[0], sl_ + 16384); glds16(vp_ + soV[1], sl_ + 16384 + 8192); } while (0)
    const int rr = 4 * g + q, swz0 = 2 * (rr & 7), ph = p >> 1;
    const unsigned vbase = (unsigned)(16384 + rr * 512 + 8 * (p & 1));
    if (has_state) { RT_ISSUE_S(0); RT_ISSUE_S(1); } else { RT_ISSUE_KV(0, sb0); if (sb0 + 1 < nsb) RT_ISSUE_KV(1, sb0 + 1); }
#pragma unroll
    for (int ks = 0; ks < 8; ++ks) asm volatile("" : "+v"(qf[ks]));
    if (has_state) {
#pragma unroll
        for (int s = 0; s < 8; ++s) {
            if (s + 1 < 8) RT_WAIT_V(2); else RT_WAIT_V(4);
            RT_BAR();
            if (s + 2 < 8) RT_ISSUE_S(s + 2); else RT_ISSUE_KV(s + 2, sb0 + s + 2 - 8);
            const LAS unsigned char* buf = F.lds + (s % 3) * RSLOT;
#pragma unroll
            for (int eh = 0; eh < 2; ++eh) {
                bf16x8 a[8];
#pragma unroll
                for (int i = 0; i < 8; ++i) a[i] = *(const LAS bf16x8*)(buf + (16 * (8 * eh + i) + fr) * 64 + g * 16);
#pragma unroll
                for (int i = 0; i < 8; ++i) acc[8 * eh + i] = __builtin_amdgcn_mfma_f32_16x16x32_bf16(a[i], qf[s], acc[8 * eh + i], 0, 0, 0);
            }
        }
        const float qd = __builtin_amdgcn_exp2f(lg);
#pragma unroll
        for (int et = 0; et < 16; ++et) acc[et] *= qd;
    }
    for (int sb = sb0; sb < nsb; ++sb) {
        const int s = nst + sb - sb0;
        if (sb + 1 < nsb) RT_WAIT_V(4); else RT_WAIT_V(0);
        RT_BAR();
        if (sb + 2 < nsb) RT_ISSUE_KV(s + 2, sb + 2);
        const LAS unsigned char* buf = F.lds + (s % 3) * RSLOT;
        if (sb <= my_sb_max) {
            int swz = swz0, frx = fr; asm volatile("" : "+v"(swz), "+v"(frx));
            f32x4 sa[2];
#pragma unroll
            for (int st = 0; st < 2; ++st) {
                bf16x8 a[8];
#pragma unroll
                for (int ks = 0; ks < 8; ++ks) a[ks] = *(const LAS bf16x8*)(buf + (16 * st + fr) * 512 + (((4 * ks + g) ^ frx) * 16));
                sa[st] = (f32x4){0.f, 0.f, 0.f, 0.f};
#pragma unroll
                for (int ks = 0; ks < 8; ++ks) sa[st] = __builtin_amdgcn_mfma_f32_16x16x32_bf16(a[ks], qf[ks], sa[st], 0, 0, 0);
            }
            float pv[8];
#pragma unroll
            for (int st = 0; st < 2; ++st)
#pragma unroll
                for (int r = 0; r < 4; ++r) {
                    const int dl = cl - (32 * sb + 16 * st + 4 * g + r);
                    pv[4 * st + r] = dl >= 0 ? sa[st][r] : 0.f;
                }
            u32x4 pu; pu.x = cvt_pk_bf16(pv[0], pv[1]); pu.y = cvt_pk_bf16(pv[2], pv[3]); pu.z = cvt_pk_bf16(pv[4], pv[5]); pu.w = cvt_pk_bf16(pv[6], pv[7]);
            const bf16x8 pf = __builtin_bit_cast(bf16x8, pu);
#pragma unroll
            for (int eq = 0; eq < 4; ++eq) {
                bf16x8 a[4];
#pragma unroll
                for (int i = 0; i < 4; ++i) { const unsigned co = (unsigned)((((2 * (4 * eq + i)) ^ swz) | ph) * 16); a[i] = cat4(tr_read(buf + vbase + co), tr_read(buf + vbase + 16 * 512 + co)); }
#pragma unroll
                for (int i = 0; i < 4; ++i) acc[4 * eq + i] = __builtin_amdgcn_mfma_f32_16x16x32_bf16(a[i], pf, acc[4 * eq + i], 0, 0, 0);
            }
        }
    }
#undef RT_ISSUE_S
#undef RT_ISSUE_KV
    const bf16_t* sgp = proj + (size_t)R * INC + 3 * RW + h * DH + 4 * g;
    u32x2 sgv[16];
#pragma unroll
    for (int et = 0; et < 16; ++et) sgv[et] = *(const u32x2*)(sgp + 16 * et);
    float ssq = 0.f;
#pragma unroll
    for (int et = 0; et < 16; ++et) ssq += (acc[et][0] * acc[et][0] + acc[et][1] * acc[et][1]) + (acc[et][2] * acc[et][2] + acc[et][3] * acc[et][3]);
    ssq += shx(ssq, 16); ssq += shx(ssq, 32);
    const float rn = __builtin_amdgcn_rsqf(ssq * (1.0f / DH) + EPS);
    bf16_t* op = cat + (size_t)R * D + h * DH + 4 * g;
    asm volatile("" : "+v"(sgv[0]), "+v"(sgv[1]), "+v"(sgv[2]), "+v"(sgv[3]), "+v"(sgv[4]), "+v"(sgv[5]), "+v"(sgv[6]), "+v"(sgv[7]), "+v"(sgv[8]), "+v"(sgv[9]), "+v"(sgv[10]), "+v"(sgv[11]), "+v"(sgv[12]), "+v"(sgv[13]), "+v"(sgv[14]), "+v"(sgv[15]));
#pragma unroll
    for (int et = 0; et < 16; ++et) {
        const u32x2 sg = sgv[et];
        u32x2 o; o.x = cvt_pk_bf16(acc[et][0] * rn * bf_lo(sg.x), acc[et][1] * rn * bf_hi(sg.x)); o.y = cvt_pk_bf16(acc[et][2] * rn * bf_lo(sg.y), acc[et][3] * rn * bf_hi(sg.y));
        *(u32x2*)(op + 16 * et) = o;
    }
    asm volatile("s_waitcnt lgkmcnt(0)" ::: "memory"); RT_BAR();
}

struct SkIn {
    bf16_t* proj; const ssq_t* ss;
    __device__ __forceinline__ void operator()(f32x4 va, f32x4 vb, int ta, int lane) const {
        const int tok = lane & 15, fq = lane >> 4, R = METAR0 + tok, kind = ta >> 7, n0 = 16 * ta + 4 * fq;
        float rstd = rstd_of(ss, R);
        if (kind < 2) rstd *= __builtin_amdgcn_exp2f((kind == 0 ? 1.0f : -1.0f) * (float)(R & 255) * head_lg((n0 >> 8) & 7));
        va *= rstd; vb *= rstd;
        if (kind < 2) {
            const float ksc = (kind == 1) ? 0.0625f : 1.0f, t = (float)tok;
#pragma unroll
            for (int r = 0; r < 4; ++r) {
                const float inv = __builtin_amdgcn_exp2f(-(float)((n0 & 255) + r) * (13.287712379549449f / 128.0f)) * 0.15915494309189535f;
                const float f = __builtin_amdgcn_fractf(t * inv), sn = __builtin_amdgcn_sinf(f), cs = __builtin_amdgcn_cosf(f);
                const float x1 = va[r], x2 = vb[r];
                va[r] = (x1 * cs - x2 * sn) * ksc; vb[r] = (x1 * sn + x2 * cs) * ksc;
            }
        } else if (kind == 3) {
#pragma unroll
            for (int r = 0; r < 4; ++r) { va[r] = silu_f(va[r]); vb[r] = silu_f(vb[r]); }
        }
        u32x2 wa, wb; wa.x = cvt_pk_bf16(va[0], va[1]); wa.y = cvt_pk_bf16(va[2], va[3]); wb.x = cvt_pk_bf16(vb[0], vb[1]); wb.y = cvt_pk_bf16(vb[2], vb[3]);
        *(u32x2*)(proj + (size_t)R * INC + n0) = wa; *(u32x2*)(proj + (size_t)R * INC + n0 + 128) = wb;
    }
};
struct SkBf {
    bf16_t* O; int ldc; const ssq_t* ss;
    __device__ __forceinline__ void operator()(f32x4 va, f32x4 vb, int ta, int lane) const {
        const int tok = lane & 15, fq = lane >> 4, R = METAR0 + tok, n0 = 16 * ta + 4 * fq;
        const float rstd = rstd_of(ss, R);
        va *= rstd; vb *= rstd;
        u32x2 wa, wb; wa.x = cvt_pk_bf16(va[0], va[1]); wa.y = cvt_pk_bf16(va[2], va[3]); wb.x = cvt_pk_bf16(vb[0], vb[1]); wb.y = cvt_pk_bf16(vb[2], vb[3]);
        *(u32x2*)(O + (size_t)R * ldc + n0) = wa; *(u32x2*)(O + (size_t)R * ldc + n0 + 128) = wb;
    }
};
struct SkRes {
    float* h; bf16_t* hb; ssq_t* ssn;
    __device__ __forceinline__ void operator()(f32x4 va, f32x4 vb, int ta, int lane) const {
        const int tok = lane & 15, fq = lane >> 4, R = METAR0 + tok, n0 = 16 * ta + 4 * fq;
        float* hp = h + (size_t)R * D + n0;
        const f32x4 a = *(const f32x4*)hp + va, b = *(const f32x4*)(hp + 128) + vb;
        *(f32x4*)hp = a; *(f32x4*)(hp + 128) = b;
        u32x2 wa, wb; wa.x = cvt_pk_bf16(a[0], a[1]); wa.y = cvt_pk_bf16(a[2], a[3]); wb.x = cvt_pk_bf16(b[0], b[1]); wb.y = cvt_pk_bf16(b[2], b[3]);
        *(u32x2*)(hb + (size_t)R * D + n0) = wa; *(u32x2*)(hb + (size_t)R * D + n0 + 128) = wb;
        float sq = (a[0] * a[0] + a[1] * a[1]) + (a[2] * a[2] + a[3] * a[3]) + (b[0] * b[0] + b[1] * b[1]) + (b[2] * b[2] + b[3] * b[3]);
        sq += shx(sq, 16); sq += shx(sq, 32);
        if (fq == 0) ssq_add(ssn, R, sq);
    }
};
struct SkUpGlu {
    bf16_t* gact; const ssq_t* ss; const float* cw; const float* cb; float* SM;
    __device__ __forceinline__ void operator()(f32x4 va, f32x4 vb, int ta, int lane) const {
        const int tok = lane & 15, fq = lane >> 4, R = METAR0 + tok, j = 128 * (ta >> 4) + 16 * (ta & 7) + 4 * fq;
        const float rstd = rstd_of(ss, R);
        const f32x4 g = va * rstd, v = vb * rstd;
        const f32x4 z = (f32x4){0.f, 0.f, 0.f, 0.f};
        const f32x4 a1 = pg8::ror16v<1>(g), a2 = pg8::ror16v<2>(g);
        const f32x4 p1 = tok >= 1 ? a1 : z, p2 = tok >= 2 ? a2 : z;
        const f32x4 ac = *(const f32x4*)(cb + j) + p2 * *(const f32x4*)(cw + j) + p1 * *(const f32x4*)(cw + DFF + j) + g * *(const f32x4*)(cw + 2 * DFF + j);
        const f32x4 o = (f32x4){silu_f(ac[0]), silu_f(ac[1]), silu_f(ac[2]), silu_f(ac[3])} * v;
        u32x2 w; w.x = cvt_pk_bf16(o[0], o[1]); w.y = cvt_pk_bf16(o[2], o[3]);
        *(u32x2*)(gact + (size_t)R * DFF + j) = w;
        if (tok >= 14) *(f32x4*)(SM + (size_t)(tok - 14) * DFF + j) = g;
    }
};
struct SkRes1 {
    const float* xsrc16; bf16_t* hb; ssq_t* ssn;
    __device__ __forceinline__ void operator()(f32x4 va, f32x4, int ta, int lane) const {
        const int tok = lane & 15, fq = lane >> 4, R = METAR0 + tok, n0 = 16 * ta + 4 * fq;
        bf16_t* bp = hb + (size_t)R * D + n0;
        f32x4 a;
        if (xsrc16) a = *(const f32x4*)(xsrc16 + (size_t)tok * D + n0); else { const u32x2 hv = *(const u32x2*)bp; a = (f32x4){bf_lo(hv.x), bf_hi(hv.x), bf_lo(hv.y), bf_hi(hv.y)}; }
        a += va;
        u32x2 wa; wa.x = cvt_pk_bf16(a[0], a[1]); wa.y = cvt_pk_bf16(a[2], a[3]);
        *(u32x2*)bp = wa;
        float sq = (a[0] * a[0] + a[1] * a[1]) + (a[2] * a[2] + a[3] * a[3]);
        sq += shx(sq, 16); sq += shx(sq, 32);
        if (fq == 0) ssq_add(ssn, R, sq);
    }
};
template <bool PAIR, class Epi, int UNR = 8>
__device__ __forceinline__ void skinny_phase(Frame& F, const bf16_t* A16, int lda, const bf16_t* Bt, int ldb, int N, int K, const Epi& E, unsigned* qctr) {
    const int tid_l = F.wave * 64 + lane_id_v();
    const int lane = tid_l & 63, w = F.wave, fr = lane & 15, fq = lane >> 4;
    const int nblk = K / 64, base = nblk / 8, rem = nblk % 8;
    const int myb = base + (w < rem ? 1 : 0), b0 = w * base + (w < rem ? w : rem);
    LAS f32x4* part = (LAS f32x4*)F.lds;
    volatile LAS unsigned* qw = (volatile LAS unsigned*)(F.lds + MISC_OFF + 64);
    const bf16_t* ap = A16 + (size_t)fr * lda + 16 * fq + 64 * b0;
    const int nitems = PAIR ? N / 32 : N / 16;
    if (tid_l == 0) qw[0] = __hip_atomic_fetch_add(qctr, 1u, __ATOMIC_RELAXED, __HIP_MEMORY_SCOPE_AGENT);
    for (int it = 0;; ++it) {
        __syncthreads();
        const int item = (int)qw[it & 1];
        if (item >= nitems) break;
        unsigned nxt = 0u;
        if (tid_l == 0) nxt = __hip_atomic_fetch_add(qctr, 1u, __ATOMIC_RELAXED, __HIP_MEMORY_SCOPE_AGENT);
        const int ta = PAIR ? 16 * (item >> 3) + (item & 7) : item;
        const bf16_t* wa = Bt + (size_t)(16 * ta + fr) * ldb + 16 * fq + 64 * b0;
        const bf16_t* wb = wa + (size_t)128 * ldb;
        f32x4 acca = (f32x4){0.f, 0.f, 0.f, 0.f}, accb = (f32x4){0.f, 0.f, 0.f, 0.f};
#pragma unroll UNR
        for (int kb = 0; kb < myb; ++kb) {
            const bf16x8 a0 = *(const bf16x8*)(ap + 64 * kb), a1 = *(const bf16x8*)(ap + 64 * kb + 8);
            const bf16x8 x0 = *(const bf16x8*)(wa + 64 * kb), x1 = *(const bf16x8*)(wa + 64 * kb + 8);
            acca = __builtin_amdgcn_mfma_f32_16x16x32_bf16(x0, a0, acca, 0, 0, 0); acca = __builtin_amdgcn_mfma_f32_16x16x32_bf16(x1, a1, acca, 0, 0, 0);
            if (PAIR) {
                const bf16x8 y0 = *(const bf16x8*)(wb + 64 * kb), y1 = *(const bf16x8*)(wb + 64 * kb + 8);
                accb = __builtin_amdgcn_mfma_f32_16x16x32_bf16(y0, a0, accb, 0, 0, 0); accb = __builtin_amdgcn_mfma_f32_16x16x32_bf16(y1, a1, accb, 0, 0, 0);
            }
        }
        part[(w * 2 + 0) * 64 + lane] = acca; if (PAIR) part[(w * 2 + 1) * 64 + lane] = accb;
        if (tid_l == 0) qw[(it + 1) & 1] = nxt;
        __syncthreads();
        if (w == 0) {
            f32x4 va = part[lane], vb = (f32x4){0.f, 0.f, 0.f, 0.f};
            if (PAIR) vb = part[64 + lane];
#pragma unroll
            for (int i = 1; i < 8; ++i) { va += part[(i * 2) * 64 + lane]; if (PAIR) vb += part[(i * 2 + 1) * 64 + lane]; }
            E(va, vb, ta, lane);
        }
    }
}

constexpr int N_PHASES = 2 + 8 * NLAYER + 1;
#ifndef MK_PER_PHASE
#define MK_PER_PHASE 0
#endif

__global__ void __launch_bounds__(NWAVES * 64, 2) hymba_fwd(Args args_k) {
    (void)args_k;
#define args (*args_ptr())
    extern __shared__ __attribute__((aligned(16))) unsigned char lds_raw[];
    Frame F;
    F.lds = (LAS unsigned char*)lds_raw;
    F.wave = __builtin_amdgcn_readfirstlane((int)threadIdx.x >> 6); F.tid = F.wave * 64 + lane_id_v(); F.lane = F.tid & 63;
    F.G = gridDim.x; { const int bx = blockIdx.x; F.vcu = (F.G % 8 == 0) ? (bx % 8) * (F.G / 8) + bx / 8 : bx; }
    unsigned char* ws = args.ws;
    unsigned* ctl = (unsigned*)(ws + WS_CTL);
    volatile LAS unsigned* MISC = (volatile LAS unsigned*)(F.lds + MISC_OFF);
    for (int u = F.tid; u < (LDS_BYTES - RING_BYTES) / 4; u += NWAVES * 64) ((LAS unsigned*)(F.lds + RING_BYTES))[u] = 0u;
    __syncthreads();
    XcdBarrier bar; bar.bar = ctl + CW_BAR; bar.x = 0; bar.st = nullptr;
    if (!MK_PER_PHASE) bar = xcd_barrier_post(ctl + CW_BAR, MISC + 8, F.wave);
#define GRID_BAR() do { if (MK_PER_PHASE) { if (F.tid == 0) __hip_atomic_store(ctl + CW_TMO, 0xBADBA0u, __ATOMIC_RELAXED, __HIP_MEMORY_SCOPE_AGENT); } else { xcd_barrier(bar, F.wave); } } while (0)
    const int lo = args.ph_lo, hi = args.ph_hi; (void)lo; (void)hi;
#if MK_PER_PHASE
#define IN(k) (lo <= (k) && (k) < hi)
#define BOTH(k) (IN(k) && IN((k) + 1))
#else
#define IN(k) true
#define BOTH(k) true
#endif

#define WSP() ((unsigned char*)args_ptr()->ws)
#define WinT ((bf16_t*)(WSP() + WS_WIN))
#define WcT ((bf16_t*)(WSP() + WS_WC))
#define WbT ((bf16_t*)(WSP() + WS_WB))
#define PoolS ((bf16_t*)(WSP() + WS_POOLS))
#define WupT ((bf16_t*)(WSP() + WS_WUP))
#define WdnT ((bf16_t*)(WSP() + WS_WDN))
#define hb ((bf16_t*)(WSP() + WS_HB))
#define proj ((bf16_t*)(WSP() + WS_PROJ))
#define cat ((bf16_t*)(WSP() + WS_CAT))
#define KV ((float*)(WSP() + WS_KV))
#define Sst ((bf16_t*)(WSP() + WS_S))
#define gact ((bf16_t*)(WSP() + WS_G))
#define ssb ((ssq_t*)((unsigned*)(WSP() + WS_CTL) + CW_SS))
#define side ((float*)(WSP() + WS_SIDE))
    const int NT = F.G * NWAVES * 64;
    const int gw = F.vcu * NWAVES + F.wave, NGW = F.G * NWAVES;
#define LAUNDERED_GT(name) const int name##_t = F.wave * 64 + lane_id_v(); const int name = F.vcu * (NWAVES * 64) + name##_t

    if (IN(0)) { p0_prologue(F, args); if (BOTH(0)) GRID_BAR(); }
    for (int l = 0; l < NLAYER; ++l) {
        const int pb = 2 + 8 * l;
        if (IN(pb + 0)) {
            pg8::Gemm g{hb, WinT + (size_t)l * INC * D, MMAIN, INC, D, D, D, 1 << 30, 0u, 1 << 30, 0u};
            pg8::StaticOrder S; S.init(MMAIN, INC, F.G, launder_s((int)blockIdx.x));
            pg8::EpiIn E{proj, ssb + (2 * l) * MP};
            {
                const bool host = (l == 0); const int xcd = launder_s((int)blockIdx.x) & 7; const int split = host ? (xcd * 6) / 8 : 0;
#pragma unroll 1
                for (int part = 0; part < 2; ++part) {
                    pg8::RangeOrder R{S, part ? split : 0, part ? (1 << 30) : split};
                    pg8::gemm_phase<pg8::EpiIn, pg8::RangeOrder, true, true>(F.lds, g, R, E, F.wave);
                    if (part == 0 && host) conv_tiles(F, args, T_IN, T_L0);
                }
            }
            { SkIn Ek{proj, ssb + (2 * l) * MP}; skinny_phase<true>(F, hb + (size_t)METAR0 * D, D, WinT + (size_t)l * INC * D, D, INC, D, Ek, ctl + CW_QCTR + 64 * (4 * l + 0)); }
            if (BOTH(pb + 0)) GRID_BAR();
        }
        if (IN(pb + 1)) {
            for (int ui = F.vcu; ui < 8 + 2 * 15 * 8 + 8; ui += F.G) {
                if (ui >= 8 + 2 * 15 * 8) { ret_unit(F, proj, Sst, cat, MMAIN, ui - (8 + 2 * 15 * 8), 1, false, 7); continue; }
                int base_row, h; float* outp;
                if (ui < 8) { h = ui; base_row = MMAIN; outp = KV + (size_t)h * DH * DH; }
                else { const int j = ui - 8, b = j / 120, n = 1 + (j % 120) / 8; h = j % 8; base_row = b * SEQ + (n - 1) * 256; outp = KV + (size_t)(8 + (b * 15 + (n - 1)) * 8 + h) * DH * DH; }
                kv_unit(F, proj, outp, base_row, h);
            }
            if (l == 0) pools_build(F, args);
            LAUNDERED_GT(gt);
            for (int i = gt; i < ((MMAIN + NMETA) / 2) * (PW / 8); i += NT) {
                const int r_ = 2 * (i / (PW / 8)), R = r_ < MMAIN ? r_ : r_ + (METAR0 - MMAIN), cg = i % (PW / 8), col = cg * 8, gi = col >> 9, t = posof(R);
                const bf16_t* pp = proj + 4 * RW + col;
                float sacc[8], sacc1[8];
                const u32x4 v0 = *(const u32x4*)(pp + (size_t)R * INC), v1 = *(const u32x4*)(pp + (size_t)(R + 1) * INC);
                const float x0[8] = {bf_lo(v0.x), bf_hi(v0.x), bf_lo(v0.y), bf_hi(v0.y), bf_lo(v0.z), bf_hi(v0.z), bf_lo(v0.w), bf_hi(v0.w)};
                const float x1[8] = {bf_lo(v1.x), bf_hi(v1.x), bf_lo(v1.y), bf_hi(v1.y), bf_lo(v1.z), bf_hi(v1.z), bf_lo(v1.w), bf_hi(v1.w)};
#pragma unroll
                for (int e = 0; e < 8; ++e) { sacc[e] = x0[e]; sacc1[e] = x1[e] + x0[e]; }
                int nd, nd1;
#define MIX_WINDOW(W) do { u32x4 v[W - 1]; _Pragma("unroll") for (int d = 1; d < W; ++d) { v[d - 1] = (u32x4){0u, 0u, 0u, 0u}; if (d <= t) v[d - 1] = *(const u32x4*)(pp + (size_t)prevrow(R, d) * INC); } \
                    _Pragma("unroll") for (int d = 1; d < W; ++d) { const float y[8] = {bf_lo(v[d - 1].x), bf_hi(v[d - 1].x), bf_lo(v[d - 1].y), bf_hi(v[d - 1].y), bf_lo(v[d - 1].z), bf_hi(v[d - 1].z), bf_lo(v[d - 1].w), bf_hi(v[d - 1].w)}; \
                        _Pragma("unroll") for (int e = 0; e < 8; ++e) { sacc[e] += y[e]; if (d < W - 1) sacc1[e] += y[e]; } } \
                    nd = (W - 1) < t ? (W - 1) : t; nd1 = (W - 1) < t + 1 ? (W - 1) : t + 1; } while (0)
                if (gi == 0) MIX_WINDOW(2); else if (gi == 1) MIX_WINDOW(4); else if (gi == 2) MIX_WINDOW(8); else MIX_WINDOW(16);
#undef MIX_WINDOW
                const float ic = 1.0f / (float)(nd + 1), ic1 = 1.0f / (float)(nd1 + 1);
                u32x4 o; o.x = cvt_pk_bf16(sacc[0] * ic - x0[0], sacc[1] * ic - x0[1]); o.y = cvt_pk_bf16(sacc[2] * ic - x0[2], sacc[3] * ic - x0[3]); o.z = cvt_pk_bf16(sacc[4] * ic - x0[4], sacc[5] * ic - x0[5]); o.w = cvt_pk_bf16(sacc[6] * ic - x0[6], sacc[7] * ic - x0[7]);
                u32x4 o1; o1.x = cvt_pk_bf16(sacc1[0] * ic1 - x1[0], sacc1[1] * ic1 - x1[1]); o1.y = cvt_pk_bf16(sacc1[2] * ic1 - x1[2], sacc1[3] * ic1 - x1[3]); o1.z = cvt_pk_bf16(sacc1[4] * ic1 - x1[4], sacc1[5] * ic1 - x1[5]); o1.w = cvt_pk_bf16(sacc1[6] * ic1 - x1[6], sacc1[7] * ic1 - x1[7]);
                *(u32x4*)(cat + (size_t)R * D + RW + col) = o;
                *(u32x4*)(cat + (size_t)(R + 1) * D + RW + col) = o1;
            }
            if (BOTH(pb + 1)) GRID_BAR();
        }
        if (IN(pb + 2)) {
            LAUNDERED_GT(gt);
            for (int i = gt; i < NB * NH * (DH * DH / 8); i += NT) {
                const int b = i / (NH * 8192), h = (i / 8192) % NH, off = (i % 8192) * 8;
                const float cd = __builtin_amdgcn_exp2f(256.0f * head_lg(h));
                const float* k0 = KV + (size_t)h * DH * DH + off;
                f32x4 s0 = *(const f32x4*)k0, s1 = *(const f32x4*)(k0 + 4);
                bf16_t* sp = Sst + ((size_t)(b * NCHK) * NH + h) * DH * DH + off;
                f32x4 av[NCHK - 1][2];
#pragma unroll
                for (int n = 1; n < NCHK; ++n) { const float* kp = KV + (size_t)(8 + (b * 15 + (n - 1)) * 8 + h) * DH * DH + off; av[n - 1][0] = *(const f32x4*)kp; av[n - 1][1] = *(const f32x4*)(kp + 4); }
                asm volatile("" : "+v"(av[0][0]), "+v"(av[0][1]), "+v"(av[1][0]), "+v"(av[1][1]), "+v"(av[2][0]), "+v"(av[2][1]), "+v"(av[3][0]), "+v"(av[3][1]), "+v"(av[4][0]), "+v"(av[4][1]), "+v"(av[5][0]), "+v"(av[5][1]), "+v"(av[6][0]), "+v"(av[6][1]), "+v"(av[7][0]));
                asm volatile("" : "+v"(av[7][1]), "+v"(av[8][0]), "+v"(av[8][1]), "+v"(av[9][0]), "+v"(av[9][1]), "+v"(av[10][0]), "+v"(av[10][1]), "+v"(av[11][0]), "+v"(av[11][1]), "+v"(av[12][0]), "+v"(av[12][1]), "+v"(av[13][0]), "+v"(av[13][1]), "+v"(av[14][0]), "+v"(av[14][1]));
                { u32x4 o; o.x = cvt_pk_bf16(s0[0], s0[1]); o.y = cvt_pk_bf16(s0[2], s0[3]); o.z = cvt_pk_bf16(s1[0], s1[1]); o.w = cvt_pk_bf16(s1[2], s1[3]); *(u32x4*)sp = o; }
#pragma unroll
                for (int n = 1; n < NCHK; ++n) {
                    const f32x4 a0 = av[n - 1][0], a1 = av[n - 1][1];
                    s0 = s0 * cd + a0; s1 = s1 * cd + a1;
                    u32x4 o; o.x = cvt_pk_bf16(s0[0], s0[1]); o.y = cvt_pk_bf16(s0[2], s0[3]); o.z = cvt_pk_bf16(s1[0], s1[1]); o.w = cvt_pk_bf16(s1[2], s1[3]);
                    *(u32x4*)(sp + (size_t)n * NH * DH * DH) = o;
                }
            }
            if (l == 0) {
                pg8::Gemm g{WbT, PoolS, NLAYER * D, PW, 512, PW, 512, 2, 1024u, 16, (unsigned)(2048 * 512 * 2)};
                pg8::StaticOrder S; S.init(NLAYER * D, PW, F.G, launder_s((int)blockIdx.x));
                pg8::EpiBf E{WcT, D, RW, nullptr};
                pg8::gemm_phase<pg8::EpiBf, pg8::StaticOrder, true, true>(F.lds, g, S, E, F.wave);
            }
            if (BOTH(pb + 2)) GRID_BAR();
        }
        if (IN(pb + 3)) {
            for (int ui = F.vcu; ui < 512; ui += F.G) {
                { const int b = ui >> 8, half = (ui & 1) ^ b, h = (ui >> 1) & 7, n = 1 + ((ui >> 4) & 15);
                    ret_unit(F, proj, Sst + ((size_t)(b * NCHK + (n - 1)) * NH + h) * DH * DH, cat, b * SEQ + (n - 1) * 256, h, half, true, 0); }
            }
            if (BOTH(pb + 3)) GRID_BAR();
        }
        if (IN(pb + 4)) {
            pg8::Gemm g{cat, WcT + (size_t)l * D * D, MMAIN, D, D, D, D, 1 << 30, 0u, 1 << 30, 0u};
            pg8::StaticOrder S; S.init(MMAIN, D, F.G, launder_s((int)blockIdx.x));
            pg8::EpiRes E{l == 0 ? args.x : nullptr, hb, ssb + (2 * l + 1) * MP, 1.0f};
            pg8::gemm_phase<pg8::EpiRes, pg8::StaticOrder, true, true>(F.lds, g, S, E, F.wave);
            { SkRes1 Ek{l == 0 ? args.meta : nullptr, hb, ssb + (2 * l + 1) * MP}; skinny_phase<false>(F, cat + (size_t)METAR0 * D, D, WcT + (size_t)l * D * D, D, D, D, Ek, ctl + CW_QCTR + 64 * (4 * l + 1)); }
            if (BOTH(pb + 4)) GRID_BAR();
        }
        if (IN(pb + 5)) {
            pg8::Gemm g{hb, WupT + (size_t)l * UPC * D, MMAIN, UPC, D, D, D, 1 << 30, 0u, 1 << 30, 0u};
            pg8::StaticOrder S; S.init(MMAIN, UPC, F.G, launder_s((int)blockIdx.x));
            const float* cw = args.conv_w + (size_t)l * 3 * DFF; const float* cbp = args.conv_b + (size_t)l * DFF;
            pg8::EpiUpGlu E{gact, ssb + (2 * l + 1) * MP, cw, cbp, side, F.lds + XCH_OFF, l == NLAYER - 1 ? 1 : 2};
            {
                const bool host = (l == 0); const int xcd = launder_s((int)blockIdx.x) & 7; const int split = host ? (xcd * 12) / 8 : 0;
#pragma unroll 1
                for (int part = 0; part < 2; ++part) {
                    pg8::RangeOrder R{S, part ? split : 0, part ? (1 << 30) : split};
                    pg8::gemm_phase<pg8::EpiUpGlu, pg8::RangeOrder, true, true>(F.lds, g, R, E, F.wave);
                    if (part == 0 && host) conv_tiles(F, args, T_L0, T_ALL);
                }
            }
            { SkUpGlu Ek{gact, ssb + (2 * l + 1) * MP, cw, cbp, side + 3 * (32 * 2 * DFF)}; skinny_phase<true>(F, hb + (size_t)METAR0 * D, D, WupT + (size_t)l * UPC * D, D, UPC, D, Ek, ctl + CW_QCTR + 64 * (4 * l + 2)); }
            if (BOTH(pb + 5)) GRID_BAR();
        }
        if (IN(pb + 6)) {
            const float* cw = args.conv_w + (size_t)l * 3 * DFF; const float* cbp = args.conv_b + (size_t)l * DFF;
            const float* SA = side; const float* SB = side + 32 * 2 * DFF; const float* SL = side + 2 * (32 * 2 * DFF); const float* SM = side + 3 * (32 * 2 * DFF);
            LAUNDERED_GT(gt);
            for (int i = gt; i < 64 * (DFF / 4); i += NT) {
                const int pr = i / (DFF / 4), j = (i % (DFF / 4)) * 4, pm = pr >> 1, r = pr & 1;
                const bool first = (pm & 15) == 0;
                const float* l0 = first ? SM : SL + (size_t)((pm - 1) * 2) * DFF;
                const float* l1 = l0 + DFF;
                const f32x4 a0 = *(const f32x4*)(SA + (size_t)(pm * 2 + r) * DFF + j), bv = *(const f32x4*)(SB + (size_t)(pm * 2 + r) * DFF + j);
                const f32x4 a1 = r ? *(const f32x4*)(SA + (size_t)(pm * 2) * DFF + j) : *(const f32x4*)(l1 + j);
                const f32x4 a2 = r ? *(const f32x4*)(l1 + j) : *(const f32x4*)(l0 + j);
                const f32x4 ac = *(const f32x4*)(cbp + j) + a2 * *(const f32x4*)(cw + j) + a1 * *(const f32x4*)(cw + DFF + j) + a0 * *(const f32x4*)(cw + 2 * DFF + j);
                const f32x4 o = (f32x4){silu_f(ac[0]), silu_f(ac[1]), silu_f(ac[2]), silu_f(ac[3])} * bv;
                u32x2 w; w.x = cvt_pk_bf16(o[0], o[1]); w.y = cvt_pk_bf16(o[2], o[3]);
                if (l == NLAYER - 1) *(unsigned*)((unsigned char*)gact + (size_t)(pm * 256 + r) * DFF + j) = pk4_fp8(o[0], o[1], o[2], o[3]);
                else if (j >= K1MIX) *(unsigned*)((unsigned char*)gact + (size_t)(pm * 256 + r) * (2 * DFF) + K1MIX + j) = pk4_fp8(o[0], o[1], o[2], o[3]);
                else *(u32x2*)(gact + (size_t)(pm * 256 + r) * DFF + j) = w;
            }
            if (BOTH(pb + 6)) GRID_BAR();
        }
        if (IN(pb + 7)) {
            pg8::StaticOrder S; S.init(MMAIN, D, F.G, launder_s((int)blockIdx.x));
            if (l == NLAYER - 1) {
                pg8::Gemm g{gact, (const bf16_t*)(ws + WS_WDN8), MMAIN, D, DFF / 2, DFF / 2, DFF / 2, 1 << 30, 0u, 1 << 30, 0u};
                pg8::PanelOrder SP; SP.init(F.G, launder_s((int)blockIdx.x));
                pg8::EpiFinal E{hb, ssb + (2 * l + 2) * MP, W8_INV, ctl + CW_PCNT, args.final_g, args.out};
                pg8::gemm_phase<pg8::EpiFinal, pg8::PanelOrder, true, true, true>(F.lds, g, SP, E, F.wave);
            } else {
                pg8::Gemm g{gact, WdnT + (size_t)l * D * DFF, MMAIN, D, K1MIX, DFF, DFF, 1 << 30, 0u, 1 << 30, 0u};
                pg8::EpiRes E{nullptr, hb, ssb + (2 * l + 2) * MP, 1.0f};
                pg8::gemm_phase_mix<pg8::EpiRes, pg8::StaticOrder>(F.lds, g, (const char*)gact + 2 * K1MIX, (const char*)(ws + WS_WDN8L0) + K1MIX, (DFF - K1MIX) / 128, S, E, F.wave);
            }
            if (l + 1 < NLAYER) { SkRes1 Ek{nullptr, hb, ssb + (2 * l + 2) * MP}; skinny_phase<false, SkRes1, 11>(
                F, gact + (size_t)METAR0 * DFF, DFF, WdnT + (size_t)l * D * DFF, DFF, D, DFF, Ek, ctl + CW_QCTR + 64 * (4 * l + 3)); }
            if (BOTH(pb + 7) && l + 1 < NLAYER) GRID_BAR();
        }
    }
#undef IN
#undef BOTH
#undef GRID_BAR
}

extern "C" void kernel_launch(void* const* d_in, const int* in_sizes, int n_in, void* d_out, int out_size, void* d_ws, size_t ws_size, hipStream_t stream) {
    static int grid = 0;
    if (grid == 0) {
        if (n_in != 13 || in_sizes[0] != MMAIN * D || out_size != MMAIN * D || ws_size < WS_END) { fprintf(stderr, "kernel_launch: unexpected shapes (n_in %d, in0 %d, out %d, ws %zu, need %zu)\n", n_in, n_in > 0 ? in_sizes[0] : -1, out_size, ws_size, (size_t)WS_END); grid = -1; return; }
        int dev = 0, cus = 0, per_cu = 0;
        if (hipGetDevice(&dev) != hipSuccess || hipDeviceGetAttribute(&cus, hipDeviceAttributeMultiprocessorCount, dev) != hipSuccess) { fprintf(stderr, "kernel_launch: device query failed\n"); grid = -1; return; }
        if (hipFuncSetAttribute((const void*)hymba_fwd, hipFuncAttributeMaxDynamicSharedMemorySize, LDS_BYTES) != hipSuccess) { fprintf(stderr, "kernel_launch: hipFuncSetAttribute failed\n"); grid = -1; return; }
        if (hipOccupancyMaxActiveBlocksPerMultiprocessor(&per_cu, (const void*)hymba_fwd, NWAVES * 64, LDS_BYTES) != hipSuccess || per_cu < 1)
            fprintf(stderr, "kernel_launch: note: occupancy query reports %d workgroups per CU\n", per_cu);
        (void)hipGetLastError();
        grid = cus;
    }
    if (grid < 0) return;
    if (hipMemsetAsync((char*)d_ws + WS_CTL, 0, CTL_ZERO_BYTES, stream) != hipSuccess) { fprintf(stderr, "kernel_launch: memset failed\n"); return; }
    if (hipMemsetAsync((char*)d_ws + WS_PROJ + (size_t)MMAIN * INC * 2, 0, (size_t)(METAR0 - MMAIN) * INC * 2, stream) != hipSuccess) { fprintf(stderr, "kernel_launch: memset failed\n"); return; }
    Args a{};
    a.x = (const float*)d_in[0]; a.meta = (const float*)d_in[1]; a.n1g = (const float*)d_in[2]; a.w_in = (const float*)d_in[3]; a.pool_w = (const float*)d_in[4]; a.pool_scale = (const float*)d_in[5];
    a.w_out = (const float*)d_in[6]; a.n2g = (const float*)d_in[7]; a.w_up = (const float*)d_in[8]; a.conv_w = (const float*)d_in[9]; a.conv_b = (const float*)d_in[10]; a.w_down = (const float*)d_in[11]; a.final_g = (const float*)d_in[12];
    a.out = (float*)d_out; a.ws = (unsigned char*)d_ws;
#if MK_PER_PHASE
    for (int p = 0; p < N_PHASES; ++p) { a.ph_lo = p; a.ph_hi = p + 1; hipLaunchKernelGGL(hymba_fwd, dim3(grid), dim3(NWAVES * 64), LDS_BYTES, stream, a); }
#else
    a.ph_lo = 0; a.ph_hi = N_PHASES;
    hipLaunchKernelGGL(hymba_fwd, dim3(grid), dim3(NWAVES * 64), LDS_BYTES, stream, a);
#endif
    const hipError_t le = hipPeekAtLastError();
    if (le != hipSuccess) fprintf(stderr, "kernel_launch: launch failed: %s\n", hipGetErrorName(le));
}
```

```cpp
#include <hip/hip_runtime.h>
#include <cstdio>
#include <cstdint>

#define LAS __attribute__((address_space(3)))
#define GAS __attribute__((address_space(1)))
typedef unsigned short bf16_t;
typedef short bf16x8 __attribute__((ext_vector_type(8)));
typedef short bf16x4 __attribute__((ext_vector_type(4)));
typedef float f32x4 __attribute__((ext_vector_type(4)));
typedef unsigned u32x4 __attribute__((ext_vector_type(4)));
typedef unsigned u32x2 __attribute__((ext_vector_type(2)));

constexpr int D = 4096, NB = 2, SEQ = 4096, NMETA = 16;
constexpr int MMAIN = NB * SEQ;
constexpr int MP = 8448;
constexpr int METAR0 = 8432;
constexpr int NH = 8, DH = 256, RW = 2048, PW = 2048;
constexpr int INC = 10240, DFF = 11008, UPC = 22016;
constexpr int NLAYER = 2;
constexpr float EPS = 1e-6f;
constexpr int NCHK = 16;

constexpr size_t MiB = 1u << 20;
constexpr size_t WS_CTL = 0, CTL_ZERO_BYTES = 1 * MiB;
constexpr size_t WS_WIN = 1 * MiB;
constexpr size_t WS_WC = WS_WIN + 160 * MiB;
constexpr size_t WS_WB = WS_WC + 64 * MiB;
constexpr size_t WS_POOLS = WS_WB + 32 * MiB;
constexpr size_t WS_WUP = WS_POOLS + 4 * MiB;
constexpr size_t WS_WDN = WS_WUP + 344 * MiB;
constexpr size_t WS_H = WS_WDN + 172 * MiB;
constexpr size_t WS_HB = WS_H + 132 * MiB;
constexpr size_t WS_PROJ = WS_HB + 66 * MiB;
constexpr size_t WS_CAT = WS_PROJ + 165 * MiB;
constexpr size_t WS_KV = WS_CAT + 66 * MiB;
constexpr size_t WS_S = WS_KV + 64 * MiB;
constexpr size_t WS_U = WS_S + 32 * MiB;
constexpr size_t WS_G = WS_U + 355 * MiB;
constexpr size_t WS_SIDE = WS_G + 178 * MiB;
constexpr size_t WS_WDN8 = WS_SIDE + 10 * MiB;
constexpr size_t WS_END = WS_WDN8 + 44 * MiB;
constexpr int K1MIX = 7424;
constexpr size_t WS_WDN8L0 = WS_H;
constexpr int CW_TMO = 0;
constexpr int CW_BAR = 4096;
constexpr int CW_QCTR = 8192;
constexpr int CW_PCNT = 16384;
constexpr int CW_SS = 65536;
static_assert(CW_SS * 4 + 5 * MP * 8 <= (int)CTL_ZERO_BYTES, "ctl");

constexpr int RING_BYTES = 131072;
constexpr int MISC_OFF = RING_BYTES + 320;
constexpr int XCH_OFF = RING_BYTES + 1024;
constexpr int LDS_BYTES = 147456;
static_assert(XCH_OFF + 4096 <= LDS_BYTES, "lds");

__device__ __forceinline__ unsigned cvt_pk_bf16(float lo, float hi) { unsigned r; asm("v_cvt_pk_bf16_f32 %0, %1, %2" : "=v"(r) : "v"(lo), "v"(hi)); return r; }
__device__ __forceinline__ float bf_lo(unsigned w) { return __uint_as_float(w << 16); }
__device__ __forceinline__ float bf_hi(unsigned w) { return __uint_as_float(w & 0xffff0000u); }
__device__ __forceinline__ float fast_rcp(float x) { return __builtin_amdgcn_rcpf(x); }
__device__ __forceinline__ float silu_f(float x) { return x * fast_rcp(1.0f + __builtin_amdgcn_exp2f(-1.4426950408889634f * x)); }
__device__ __forceinline__ int posof(int R) { return R < MMAIN ? NMETA + (R & (SEQ - 1)) : (R >= METAR0 ? R - METAR0 : 0); }
__device__ __forceinline__ int prevrow(int R, int d) {
    if (R < MMAIN) { const int i = R & (SEQ - 1); return d <= i ? R - d : MP + (i - d); }
    return R - d;
}
__device__ __forceinline__ int lane_id_v() { int l; asm volatile("v_mbcnt_lo_u32_b32 %0, -1, 0\n\tv_mbcnt_hi_u32_b32 %0, -1, %0" : "=v"(l)); return l; }
__device__ __forceinline__ float shx(float x, int m) { return __builtin_bit_cast(float, __builtin_amdgcn_ds_bpermute((lane_id_v() ^ m) << 2, __builtin_bit_cast(int, x))); }
__device__ __forceinline__ float wave_sum(float v) {
#pragma unroll
    for (int o = 1; o < 64; o <<= 1) v += shx(v, o);
    return v;
}
__device__ __forceinline__ int launder_s(int v) { asm volatile("" : "+s"(v)); return v; }
typedef unsigned long long ssq_t;
constexpr float SSQ_SCALE = 1048576.0f, SSQ_INV = 1.0f / 1048576.0f;
__device__ __forceinline__ float rstd_of(const ssq_t* ss, int R) { return __builtin_amdgcn_rsqf((float)ss[R] * (SSQ_INV / D) + EPS); }
__device__ __forceinline__ void rstd8(const ssq_t* ss, int r0, float (&rs)[2][4]) {
    ssq_t q[8];
#pragma unroll
    for (int i = 0; i < 8; ++i) q[i] = ss[r0 + (i >> 2) * 128 + (i & 3) * 16];
    asm volatile("" : "+v"(q[0]), "+v"(q[1]), "+v"(q[2]), "+v"(q[3]), "+v"(q[4]), "+v"(q[5]), "+v"(q[6]), "+v"(q[7]));
#pragma unroll
    for (int i = 0; i < 8; ++i) rs[i >> 2][i & 3] = __builtin_amdgcn_rsqf((float)q[i] * (SSQ_INV / D) + EPS);
}
__device__ __forceinline__ void ssq_add(ssq_t* ss, int R, float sq) { __hip_atomic_fetch_add(ss + R, (ssq_t)(sq * SSQ_SCALE + 0.5f), __ATOMIC_RELAXED, __HIP_MEMORY_SCOPE_AGENT); }
__device__ __forceinline__ unsigned pk4_fp8(float a, float b, float c, float d) { int p = __builtin_amdgcn_cvt_pk_fp8_f32(a, b, 0, false); p = __builtin_amdgcn_cvt_pk_fp8_f32(c, d, p, true); return (unsigned)p; }
constexpr float W8_SCALE = 64.0f, W8_INV = 1.0f / 64.0f;
#define LDS_WAIT() asm volatile("s_waitcnt lgkmcnt(0)" ::: "memory")
#define VM_WAIT() asm volatile("s_waitcnt vmcnt(0)" ::: "memory")

__device__ __forceinline__ float head_lg(int h) { return log2f(1.0f - __builtin_amdgcn_exp2f(-5.0f - (float)h)); }
namespace pg8 {
constexpr int BM = 256, BK = 64, HALF = 128, HTB = HALF * BK * 2, STAGE_BYTES = 8 * HTB, NXCD = 8, WGM = 8;
__host__ __device__ __forceinline__ int lds_byte(int r, int c) { const int st = (r >> 4) * 2 + (c >> 5), rr = r & 15, cc = c & 31, ob = rr * 64 + cc * 2; return st * 1024 + (ob ^ (((ob >> 9) & 1) << 5)); }
__host__ __device__ __forceinline__ void stage_rc(int b, int& R, int& C) { const int st = b / 1024, sb = b % 1024, swz = sb ^ (((sb >> 9) & 1) << 5); R = (st >> 1) * 16 + swz / 64; C = (st & 1) * 32 + (swz % 64) / 2; }
__host__ __device__ __forceinline__ int perm32(int rho) { const int n = rho >> 4, i = rho & 15; return 8 * (i >> 2) + 4 * n + (i & 3); }

typedef int i32x8 __attribute__((ext_vector_type(8))); typedef int i32x4v __attribute__((ext_vector_type(4)));
__device__ __forceinline__ i32x8 pk8(bf16x8 lo, bf16x8 hi) { return __builtin_shufflevector(__builtin_bit_cast(i32x4v, lo), __builtin_bit_cast(i32x4v, hi), 0, 1, 2, 3, 4, 5, 6, 7); }
struct Unit { int pm, pn; };
struct Gemm { const bf16_t* A; const bf16_t* Bt; int M, N, K, lda, ldb; int agrp; unsigned agrp_bytes; int bgrp; unsigned bgrp_bytes; };

struct StaticOrder {
    int nM, nN, nwg, G, c;
    __host__ __device__ void init(int M, int N, int G_, int c_) { nM = M / BM; nN = N / BM; nwg = nM * nN; G = G_; c = c_; }
    __host__ __device__ bool next(int i, Unit& u) const {
        const long L = (long)i * G + c; if (L >= nwg) return false;
        int wgid = (int)L; { const int q = nwg / NXCD, r = nwg % NXCD, xcd = wgid % NXCD, off = wgid / NXCD; wgid = (xcd < r ? xcd * (q + 1) : r * (q + 1) + (xcd - r) * q) + off; }
        const int nig = WGM * nN, gid = wgid / nig, fm = gid * WGM, gsz = (nM - fm) < WGM ? (nM - fm) : WGM;
        u.pm = fm + ((wgid % nig) % gsz); u.pn = (wgid % nig) / gsz; return true;
    }
    __device__ __forceinline__ void a_ready(const Unit&) const {}
    __device__ __forceinline__ void done(const Unit&) const {}
};
struct RangeOrder {
    StaticOrder s; int i0, i1;
    __device__ __forceinline__ bool next(int i, Unit& u) const { return (i0 + i < i1) && s.next(i0 + i, u); }
    __device__ __forceinline__ void a_ready(const Unit&) const {}
    __device__ __forceinline__ void done(const Unit&) const {}
};
struct PanelOrder {
    int G, bx;
    __device__ __forceinline__ void init(int G_, int bx_) { G = G_; bx = bx_; }
    __device__ __forceinline__ bool next(int i, Unit& u) const {
        if (G == 256) { if (i >= 2) return false; const int x = bx & 7, k = bx >> 3; u.pm = 16 * i + 4 * (x >> 1) + (k & 3); u.pn = 8 * (x & 1) + (k >> 2); return true; }
        const int P = G / 16; if (P == 0 || bx >= 16 * P) return false;
        const int pm = i * P + bx / 16; if (i * P >= 32 || pm >= 32) return false;
        u.pm = pm; u.pn = bx % 16; return true;
    }
    __device__ __forceinline__ void a_ready(const Unit&) const {}
    __device__ __forceinline__ void done(const Unit&) const {}
};


struct EpiIn {
    static constexpr bool PERM = true, AFTER_DRAIN = false;
    bf16_t* proj; const ssq_t* ss;
    __device__ __forceinline__ void operator()(const f32x4 (&acc)[2][2][4][2], const Unit& u, int wr, int wc, int fr, int fq) const {
        const int row0 = u.pm * BM + wr * 64 + fr, kind = u.pn >> 3, colt = u.pn * BM + wc * 32 + 8 * fq;
        float invr[8];
#pragma unroll
        for (int e = 0; e < 8; ++e) invr[e] = __builtin_amdgcn_exp2f(-(float)(wc * 32 + 8 * fq + e) * (13.287712379549449f / 128.0f)) * 0.15915494309189535f;
        const float ksc = (kind == 1) ? 0.0625f : 1.0f;
        const float hlg = head_lg(u.pn & 7);
        float rsv[2][4]; rstd8(ss, row0, rsv);
#pragma unroll
        for (int ai = 0; ai < 2; ++ai)
#pragma unroll
            for (int m = 0; m < 4; ++m) {
                const int R = row0 + ai * HALF + m * 16;
                float rstd = rsv[ai][m];
                if (kind < 2) rstd *= __builtin_amdgcn_exp2f((kind == 0 ? 1.0f : -1.0f) * (float)(R & 255) * hlg);
                f32x4 v[2][2];
#pragma unroll
                for (int bj = 0; bj < 2; ++bj)
#pragma unroll
                    for (int n = 0; n < 2; ++n) v[bj][n] = acc[ai][bj][m][n] * rstd;
                if (kind < 2) {
                    const float t = (float)posof(R);
#pragma unroll
                    for (int n = 0; n < 2; ++n)
#pragma unroll
                        for (int j = 0; j < 4; ++j) {
                            const float f = __builtin_amdgcn_fractf(t * invr[4 * n + j]);
                            const float sn = __builtin_amdgcn_sinf(f), cs = __builtin_amdgcn_cosf(f);
                            const float x1 = v[0][n][j], x2 = v[1][n][j];
                            v[0][n][j] = (x1 * cs - x2 * sn) * ksc; v[1][n][j] = (x1 * sn + x2 * cs) * ksc;
                        }
                } else if (kind == 3) {
#pragma unroll
                    for (int bj = 0; bj < 2; ++bj)
#pragma unroll
                        for (int n = 0; n < 2; ++n)
#pragma unroll
                            for (int j = 0; j < 4; ++j) v[bj][n][j] = silu_f(v[bj][n][j]);
                }
                bf16_t* rowp = proj + (size_t)R * INC + colt;
#pragma unroll
                for (int bj = 0; bj < 2; ++bj) {
                    u32x4 w; w.x = cvt_pk_bf16(v[bj][0][0], v[bj][0][1]); w.y = cvt_pk_bf16(v[bj][0][2], v[bj][0][3]); w.z = cvt_pk_bf16(v[bj][1][0], v[bj][1][1]); w.w = cvt_pk_bf16(v[bj][1][2], v[bj][1][3]);
                    *(u32x4*)(rowp + bj * HALF) = w;
                }
            }
    }
};
struct EpiBf {
    static constexpr bool PERM = true, AFTER_DRAIN = false;
    bf16_t* O; int ldc; int coloff; const ssq_t* ss;
    __device__ __forceinline__ void operator()(const f32x4 (&acc)[2][2][4][2], const Unit& u, int wr, int wc, int fr, int fq) const {
        const int row0 = u.pm * BM + wr * 64 + fr, colt = coloff + u.pn * BM + wc * 32 + 8 * fq;
#pragma unroll
        for (int ai = 0; ai < 2; ++ai)
#pragma unroll
            for (int m = 0; m < 4; ++m) {
                const int R = row0 + ai * HALF + m * 16;
                const float rstd = ss ? rstd_of(ss, R) : 1.0f;
                bf16_t* rowp = O + (size_t)R * ldc + colt;
#pragma unroll
                for (int bj = 0; bj < 2; ++bj) {
                    const f32x4 v0 = acc[ai][bj][m][0] * rstd, v1 = acc[ai][bj][m][1] * rstd;
                    u32x4 w; w.x = cvt_pk_bf16(v0[0], v0[1]); w.y = cvt_pk_bf16(v0[2], v0[3]); w.z = cvt_pk_bf16(v1[0], v1[1]); w.w = cvt_pk_bf16(v1[2], v1[3]);
                    *(u32x4*)(rowp + bj * HALF) = w;
                }
            }
    }
};
struct EpiRes {
    static constexpr bool PERM = true, AFTER_DRAIN = false;
    const float* xsrc; bf16_t* hb; ssq_t* ssn; float sc;
    __device__ __forceinline__ void operator()(const f32x4 (&acc)[2][2][4][2], const Unit& u, int wr, int wc, int fr, int fq) const {
        const int row0 = u.pm * BM + wr * 64 + fr, colt = u.pn * BM + wc * 32 + 8 * fq;
        if (xsrc) {
#pragma unroll
            for (int ai = 0; ai < 2; ++ai) {
                f32x4 xv[4][2][2];
#pragma unroll
                for (int m = 0; m < 4; ++m)
#pragma unroll
                    for (int bj = 0; bj < 2; ++bj) { const float* sp = xsrc + (size_t)(row0 + ai * HALF + m * 16) * D + colt + bj * HALF; xv[m][bj][0] = *(const f32x4*)sp; xv[m][bj][1] = *(const f32x4*)(sp + 4); }
#pragma unroll
                for (int m = 0; m < 4; ++m) {
                    const int R = row0 + ai * HALF + m * 16;
                    float sq = 0.f;
#pragma unroll
                    for (int bj = 0; bj < 2; ++bj) {
                        const f32x4 a0 = xv[m][bj][0] + acc[ai][bj][m][0] * sc, a1 = xv[m][bj][1] + acc[ai][bj][m][1] * sc;
                        sq += (a0[0] * a0[0] + a0[1] * a0[1]) + (a0[2] * a0[2] + a0[3] * a0[3]) + (a1[0] * a1[0] + a1[1] * a1[1]) + (a1[2] * a1[2] + a1[3] * a1[3]);
                        u32x4 w; w.x = cvt_pk_bf16(a0[0], a0[1]); w.y = cvt_pk_bf16(a0[2], a0[3]); w.z = cvt_pk_bf16(a1[0], a1[1]); w.w = cvt_pk_bf16(a1[2], a1[3]);
                        *(u32x4*)(hb + (size_t)R * D + colt + bj * HALF) = w;
                    }
                    sq += shx(sq, 16); sq += shx(sq, 32);
                    if (fq == 0) ssq_add(ssn, R, sq);
                }
            }
        } else {
            u32x4 hv[2][4][2];
#pragma unroll
            for (int m = 0; m < 4; ++m)
#pragma unroll
                for (int bj = 0; bj < 2; ++bj) hv[0][m][bj] = *(const u32x4*)(hb + (size_t)(row0 + m * 16) * D + colt + bj * HALF);
#pragma unroll
            for (int m = 0; m < 2; ++m)
#pragma unroll
                for (int bj = 0; bj < 2; ++bj) hv[1][m][bj] = *(const u32x4*)(hb + (size_t)(row0 + HALF + m * 16) * D + colt + bj * HALF);
#pragma unroll
            for (int ai = 0; ai < 2; ++ai) {
                if (ai == 1) {
#pragma unroll
                    for (int m = 2; m < 4; ++m)
#pragma unroll
                        for (int bj = 0; bj < 2; ++bj) hv[1][m][bj] = *(const u32x4*)(hb + (size_t)(row0 + HALF + m * 16) * D + colt + bj * HALF);
                }
#pragma unroll
                for (int m = 0; m < 4; ++m) {
                    const int R = row0 + ai * HALF + m * 16;
                    float sq = 0.f;
#pragma unroll
                    for (int bj = 0; bj < 2; ++bj) {
                        const u32x4 h4 = hv[ai][m][bj];
                        f32x4 a0 = (f32x4){bf_lo(h4.x), bf_hi(h4.x), bf_lo(h4.y), bf_hi(h4.y)}, a1 = (f32x4){bf_lo(h4.z), bf_hi(h4.z), bf_lo(h4.w), bf_hi(h4.w)};
                        a0 += acc[ai][bj][m][0] * sc; a1 += acc[ai][bj][m][1] * sc;
                        sq += (a0[0] * a0[0] + a0[1] * a0[1]) + (a0[2] * a0[2] + a0[3] * a0[3]) + (a1[0] * a1[0] + a1[1] * a1[1]) + (a1[2] * a1[2] + a1[3] * a1[3]);
                        u32x4 w; w.x = cvt_pk_bf16(a0[0], a0[1]); w.y = cvt_pk_bf16(a0[2], a0[3]); w.z = cvt_pk_bf16(a1[0], a1[1]); w.w = cvt_pk_bf16(a1[2], a1[3]);
                        *(u32x4*)(hb + (size_t)R * D + colt + bj * HALF) = w;
                    }
                    sq += shx(sq, 16); sq += shx(sq, 32);
                    if (fq == 0) ssq_add(ssn, R, sq);
                }
            }
        }
    }
};

struct EpiFinal {
    static constexpr bool PERM = true, AFTER_DRAIN = false;
    const bf16_t* hb; ssq_t* ssn; float sc; unsigned* pcnt; const float* fg; float* out;
    __device__ __forceinline__ void operator()(f32x4 (&acc)[2][2][4][2], const Unit& u, int wr, int wc, int fr, int fq) const {
        const int row0 = u.pm * BM + wr * 64 + fr, colt = u.pn * BM + wc * 32 + 8 * fq;
        u32x4 hv[2][4][2];
#pragma unroll
        for (int ai = 0; ai < 2; ++ai)
#pragma unroll
            for (int m = 0; m < 4; ++m)
#pragma unroll
                for (int bj = 0; bj < 2; ++bj) hv[ai][m][bj] = *(const u32x4*)(hb + (size_t)(row0 + ai * HALF + m * 16) * D + colt + bj * HALF);
        f32x4 g4[2][2];
#pragma unroll
        for (int bj = 0; bj < 2; ++bj) { g4[bj][0] = *(const f32x4*)(fg + colt + bj * HALF); g4[bj][1] = *(const f32x4*)(fg + colt + bj * HALF + 4); }
#pragma unroll
        for (int ai = 0; ai < 2; ++ai)
#pragma unroll
            for (int m = 0; m < 4; ++m) {
                const int R = row0 + ai * HALF + m * 16;
                float sq = 0.f;
#pragma unroll
                for (int bj = 0; bj < 2; ++bj) {
                    const u32x4 h4 = hv[ai][m][bj];
                    f32x4 a0 = (f32x4){bf_lo(h4.x), bf_hi(h4.x), bf_lo(h4.y), bf_hi(h4.y)}, a1 = (f32x4){bf_lo(h4.z), bf_hi(h4.z), bf_lo(h4.w), bf_hi(h4.w)};
                    a0 += acc[ai][bj][m][0] * sc; a1 += acc[ai][bj][m][1] * sc;
                    sq += (a0[0] * a0[0] + a0[1] * a0[1]) + (a0[2] * a0[2] + a0[3] * a0[3]) + (a1[0] * a1[0] + a1[1] * a1[1]) + (a1[2] * a1[2] + a1[3] * a1[3]);
                    acc[ai][bj][m][0] = a0; acc[ai][bj][m][1] = a1;
                }
                sq += shx(sq, 16); sq += shx(sq, 32);
                if (fq == 0) ssq_add(ssn, R, sq);
            }
        asm volatile("s_waitcnt vmcnt(0)" ::: "memory");
        __builtin_amdgcn_s_barrier();
        if (wr == 0 && wc == 0 && lane_id_v() == 0) {
            unsigned* pc = pcnt + 16 * u.pm;
            __hip_atomic_fetch_add(pc, 1u, __ATOMIC_RELAXED, __HIP_MEMORY_SCOPE_AGENT);
            unsigned sp = 0;
            while (__hip_atomic_load(pc, __ATOMIC_RELAXED, __HIP_MEMORY_SCOPE_AGENT) < 16u) { __builtin_amdgcn_s_sleep(1); if (++sp > (1u << 22)) break; }
        }
        asm volatile("" ::: "memory");
        __builtin_amdgcn_s_barrier();
        asm volatile("" ::: "memory");
        ssq_t q[8];
#pragma unroll
        for (int i = 0; i < 8; ++i) q[i] = __hip_atomic_load(ssn + row0 + (i >> 2) * HALF + (i & 3) * 16, __ATOMIC_RELAXED, __HIP_MEMORY_SCOPE_AGENT);
        asm volatile("" : "+v"(q[0]), "+v"(q[1]), "+v"(q[2]), "+v"(q[3]), "+v"(q[4]), "+v"(q[5]), "+v"(q[6]), "+v"(q[7]));
#pragma unroll
        for (int ai = 0; ai < 2; ++ai)
#pragma unroll
            for (int m = 0; m < 4; ++m) {
                const int R = row0 + ai * HALF + m * 16;
                const float rstd = __builtin_amdgcn_rsqf((float)q[ai * 4 + m] * (SSQ_INV / D) + EPS);
#pragma unroll
                for (int bj = 0; bj < 2; ++bj) {
                    float* op = out + (size_t)R * D + colt + bj * HALF;
                    *(f32x4*)op = acc[ai][bj][m][0] * rstd * g4[bj][0]; *(f32x4*)(op + 4) = acc[ai][bj][m][1] * rstd * g4[bj][1];
                }
            }
    }
};


template <int N> __device__ __forceinline__ float ror16(float x) { return __builtin_bit_cast(float, __builtin_amdgcn_mov_dpp(__builtin_bit_cast(int, x), 0x120 | N, 0xf, 0xf, false)); }
template <int N> __device__ __forceinline__ f32x4 ror16v(f32x4 v) { return (f32x4){ror16<N>(v[0]), ror16<N>(v[1]), ror16<N>(v[2]), ror16<N>(v[3])}; }
struct EpiUpGlu {
    static constexpr bool PERM = true, AFTER_DRAIN = false;
    bf16_t* gact; const ssq_t* ss; const float* cw; const float* cb; float* side; LAS unsigned char* xl; int f8;
    __device__ __forceinline__ void operator()(const f32x4 (&acc)[2][2][4][2], const Unit& u, int wr, int wc, int fr, int fq) const {
        const int jc = u.pn * 128 + wc * 32 + 8 * fq, rowb = u.pm * BM + wr * 64;
        const bool f8u = f8 == 1 || (f8 == 2 && u.pn * 128 >= K1MIX);
        f32x4 w0[2], w1[2], w2[2], cbv[2];
#pragma unroll
        for (int n = 0; n < 2; ++n) { w0[n] = *(const f32x4*)(cw + jc + 4 * n); w1[n] = *(const f32x4*)(cw + DFF + jc + 4 * n); w2[n] = *(const f32x4*)(cw + 2 * DFF + jc + 4 * n); cbv[n] = *(const f32x4*)(cb + jc + 4 * n); }
        constexpr float NL2E = -1.4426950408889634f, NLN2 = -0.6931471805599453f;
#pragma unroll
        for (int n = 0; n < 2; ++n) { w0[n] *= NL2E; w1[n] *= NL2E; w2[n] *= NL2E; cbv[n] *= NL2E; }
        float rsv[2][4]; rstd8(ss, rowb + fr, rsv);
#pragma unroll
        for (int ai = 0; ai < 2; ++ai) {
            const float r3 = rsv[ai][3];
            if (fr >= 14) {
                LAS unsigned char* p = xl + ((((ai * 2 + wr) * 4 + wc) * 2 + (fr - 14)) * 128) + fq * 32;
                *(LAS f32x4*)p = acc[ai][0][3][0] * r3; *(LAS f32x4*)(p + 16) = acc[ai][0][3][1] * r3;
            }
        }
        asm volatile("s_waitcnt lgkmcnt(0)" ::: "memory"); __builtin_amdgcn_s_barrier(); asm volatile("" ::: "memory");
        float* SA = side; float* SB = side + 32 * 2 * DFF; float* SL = side + 2 * (32 * 2 * DFF);
#pragma unroll
        for (int ai = 0; ai < 2; ++ai) {
            const bool have_pred = (ai * 2 + wr) != 0;
            f32x4 B1[2], B2[2];
            { const LAS unsigned char* p = xl + (((((ai * 2 + wr) - 1) & 3) * 4 + wc) * 2) * 128 + fq * 32;
              B2[0] = *(const LAS f32x4*)p; B2[1] = *(const LAS f32x4*)(p + 16); B1[0] = *(const LAS f32x4*)(p + 128); B1[1] = *(const LAS f32x4*)(p + 144); }
            f32x4 gp[2] = {B1[0], B1[1]};
#pragma unroll
            for (int m = 0; m < 4; ++m) {
                const int R = rowb + ai * HALF + m * 16 + fr;
                const float rs = rsv[ai][m], rsn = rs * NLN2;
                f32x4 g[2], v[2], o[2];
#pragma unroll
                for (int n = 0; n < 2; ++n) { g[n] = acc[ai][0][m][n] * rs; v[n] = acc[ai][1][m][n] * rsn; }
#pragma unroll
                for (int n = 0; n < 2; ++n) {
                    f32x4 y1, y2;
                    if (m > 0) { y1 = fr == 15 ? gp[n] : g[n]; y2 = fr >= 14 ? gp[n] : g[n]; }
                    else { y1 = fr == 15 ? B1[n] : g[n]; y2 = fr == 15 ? B1[n] : (fr == 14 ? B2[n] : g[n]); }
                    const f32x4 p1 = ror16v<1>(y1), p2 = ror16v<2>(y2);
                    const f32x4 z = cbv[n] + p2 * w0[n] + p1 * w1[n] + g[n] * w2[n];
                    f32x4 q;
#pragma unroll
                    for (int j = 0; j < 4; ++j) q[j] = z[j] * __builtin_amdgcn_rcpf(1.0f + __builtin_amdgcn_exp2f(z[j]));
                    o[n] = q * v[n];
                }
                if (have_pred || m > 0 || fr >= 2) {
                    if (f8u) { u32x2 w8; w8.x = pk4_fp8(o[0][0], o[0][1], o[0][2], o[0][3]); w8.y = pk4_fp8(o[1][0], o[1][1], o[1][2], o[1][3]); __builtin_nontemporal_store(w8, (u32x2*)((unsigned char*)gact + (f8 == 1 ? (size_t)R * DFF + jc : (size_t)R * (2 * DFF) + K1MIX + jc))); }
                    else {
                    u32x4 w; w.x = cvt_pk_bf16(o[0][0], o[0][1]); w.y = cvt_pk_bf16(o[0][2], o[0][3]); w.z = cvt_pk_bf16(o[1][0], o[1][1]); w.w = cvt_pk_bf16(o[1][2], o[1][3]);
                    __builtin_nontemporal_store(w, (u32x4*)(gact + (size_t)R * DFF + jc)); }
                } else {
                    float* pa = SA + (size_t)(u.pm * 2 + fr) * DFF + jc; float* pb = SB + (size_t)(u.pm * 2 + fr) * DFF + jc;
                    *(f32x4*)pa = g[0]; *(f32x4*)(pa + 4) = g[1]; *(f32x4*)pb = acc[ai][1][m][0] * rs; *(f32x4*)(pb + 4) = acc[ai][1][m][1] * rs;
                }
                if (ai == 1 && wr == 1 && m == 3 && fr >= 14) { float* pl = SL + (size_t)(u.pm * 2 + (fr - 14)) * DFF + jc; *(f32x4*)pl = g[0]; *(f32x4*)(pl + 4) = g[1]; }
                gp[0] = g[0]; gp[1] = g[1];
            }
        }
    }
};
template <class Epi, class Sched, bool ALIGN_EPI = false, bool SP2 = false, bool F8 = false>
__device__ __forceinline__ void gemm_phase(LAS unsigned char* lds, const Gemm g, const Sched& S, const Epi& E, int wv) {
    wv = launder_s(wv);
    const int tid_l = wv * 64 + lane_id_v();
    const int tid = tid_l, wid = wv, lane = tid & 63, wr = wid >> 2, wc = wid & 3, fr = lane & 15, fq = lane >> 4;
    const int K = g.K, nt = K / BK;
    unsigned voffA[2], voffB[2];
#pragma unroll
    for (int i = 0; i < 2; ++i) { int R, C; stage_rc(tid * 16 + i * 8192, R, C); const int Rb = Epi::PERM ? ((R & ~31) + perm32(R & 31)) : R;
        voffA[i] = (unsigned)(R * g.lda + C) * 2u; voffB[i] = (unsigned)(Rb * g.ldb + C) * 2u; }
    const size_t kstep = (size_t)(BK * 2);
    const size_t hstepA = (size_t)HALF * g.lda * 2, hstepB = (size_t)HALF * g.ldb * 2;
    const size_t tstepA = 2 * hstepA, tstepB = 2 * hstepB;
    const unsigned ldsw = (unsigned)wid * 1024u, ldsbase = (unsigned)(size_t)lds;
    const int aoff = lds_byte(wr * 64 + fr, fq * 8), boff = lds_byte(wc * 32 + fr, fq * 8);
#define PG8_SA(b, h) (((b) * 2 + (h)) * HTB)
#define PG8_SB(b, h) ((4 + (b) * 2 + (h)) * HTB)
#define PG8_STAGE(bufoff, gbase, voff) do { _Pragma("unroll") for (int _i = 0; _i < 2; ++_i) \
        asm volatile("s_mov_b32 m0, %2\n\ts_nop 0\n\tglobal_load_lds_dwordx4 %0, %1" :: "v"((voff)[_i]), "s"((const char*)(gbase)), "s"(ldsbase + (unsigned)(bufoff) + ldsw + (unsigned)(_i * 8192)) : "memory", "m0"); } while (0)
#define PG8_LDA(dst, b, h) do { _Pragma("unroll") for (int m = 0; m < 4; ++m) _Pragma("unroll") for (int k = 0; k < 2; ++k) dst[m][k] = *(const LAS bf16x8*)(lds + PG8_SA(b, h) + aoff + m * 2048 + k * 1024); } while (0)
#define PG8_LDB(dst, b, h) do { _Pragma("unroll") for (int n = 0; n < 2; ++n) _Pragma("unroll") for (int k = 0; k < 2; ++k) dst[n][k] = *(const LAS bf16x8*)(lds + PG8_SB(b, h) + boff + n * 2048 + k * 1024); } while (0)
#define PG8_MMA(ai, bj, At, Bt) do { __builtin_amdgcn_s_setprio(1); _Pragma("unroll") for (int m = 0; m < 4; ++m) _Pragma("unroll") for (int n = 0; n < 2; ++n) { \
        if constexpr (F8) acc[ai][bj][m][n] = __builtin_amdgcn_mfma_scale_f32_16x16x128_f8f6f4(pk8(Bt[n][0], Bt[n][1]), pk8(At[m][0], At[m][1]), acc[ai][bj][m][n], 0, 0, 0, 0x7f7f7f7f, 0, 0x7f7f7f7f); \
        else { _Pragma("unroll") for (int k = 0; k < 2; ++k) acc[ai][bj][m][n] = __builtin_amdgcn_mfma_f32_16x16x32_bf16(Bt[n][k], At[m][k], acc[ai][bj][m][n], 0, 0, 0); } } __builtin_amdgcn_s_setprio(0); } while (0)
#define PG8_WAIT_V(n) asm volatile("s_waitcnt vmcnt(" #n ")" ::: "memory")
#define PG8_WAIT_L(n) asm volatile("s_waitcnt lgkmcnt(" #n ")" ::: "memory")
#define PG8_BAR __builtin_amdgcn_s_barrier()
#define PG8_SCHED __builtin_amdgcn_sched_barrier(0)
#define PG8_ABASE(u) ((const char*)g.A + (size_t)(u).pm * tstepA + (size_t)((u).pn / g.agrp) * g.agrp_bytes)
#define PG8_BBASE(u) ((const char*)g.Bt + (size_t)(u).pn * tstepB + (size_t)((u).pm / g.bgrp) * g.bgrp_bytes)
    Unit cur, nxt; int ui = 0;
    if (!S.next(0, cur)) return;
    f32x4 acc[2][2][4][2];
#pragma unroll
    for (int a = 0; a < 2; ++a)
#pragma unroll
        for (int b = 0; b < 2; ++b)
#pragma unroll
            for (int m = 0; m < 4; ++m)
#pragma unroll
                for (int n = 0; n < 2; ++n) acc[a][b][m][n] = (f32x4){0.f, 0.f, 0.f, 0.f};
    bf16x8 At[4][2], B0[2][2], B1[2][2];
    const char* cA = PG8_ABASE(cur); const char* cB = PG8_BBASE(cur);
    S.a_ready(cur);
    if constexpr (SP2) {
        PG8_STAGE(PG8_SB(0, 0), cB, voffB); PG8_STAGE(PG8_SB(0, 1), cB + hstepB, voffB); PG8_STAGE(PG8_SA(0, 0), cA, voffA); PG8_STAGE(PG8_SA(0, 1), cA + hstepA, voffA);
        if (wr == 1) PG8_BAR;
        PG8_WAIT_V(2); PG8_BAR;
        PG8_STAGE(PG8_SB(1, 0), cB + kstep, voffB); PG8_STAGE(PG8_SA(1, 0), cA + kstep, voffA); PG8_STAGE(PG8_SB(1, 1), cB + hstepB + kstep, voffB);
        PG8_WAIT_V(6); PG8_BAR;
    } else {
        PG8_STAGE(PG8_SB(0, 0), cB, voffB); PG8_STAGE(PG8_SA(0, 0), cA, voffA); PG8_STAGE(PG8_SB(0, 1), cB + hstepB, voffB); PG8_STAGE(PG8_SA(0, 1), cA + hstepA, voffA);
        if (wr == 1) PG8_BAR;
        PG8_WAIT_V(4); PG8_BAR;
        PG8_STAGE(PG8_SB(1, 0), cB + kstep, voffB); PG8_STAGE(PG8_SA(1, 0), cA + kstep, voffA); PG8_STAGE(PG8_SB(1, 1), cB + hstepB + kstep, voffB);
        PG8_WAIT_V(6); PG8_BAR;
    }
    for (;;) {
        const bool has_next = S.next(ui + 1, nxt);
        const char* nA = has_next ? PG8_ABASE(nxt) : cA; const char* nB = has_next ? PG8_BBASE(nxt) : cB;
        for (int t = 0; t < nt; t += 2) {
            const bool last = (t == nt - 2);
            const char* a1 = cA + (size_t)(t + 1) * kstep;
            const char* a2 = last ? nA : cA + (size_t)(t + 2) * kstep; const char* b2 = last ? nB : cB + (size_t)(t + 2) * kstep;
            const char* a3 = a2 + kstep; const char* b3 = b2 + kstep;
            if (last && has_next) S.a_ready(nxt);
            if constexpr (SP2) {
            PG8_LDB(B0, 0, 0); PG8_LDB(B1, 0, 1); PG8_SCHED; PG8_LDA(At, 0, 0); PG8_STAGE(PG8_SA(1, 1), a1 + hstepA, voffA);
            PG8_WAIT_V(8); PG8_WAIT_L(0); PG8_BAR; PG8_MMA(0, 0, At, B0); PG8_MMA(0, 1, At, B1); PG8_BAR; PG8_SCHED;
            PG8_LDA(At, 0, 1); PG8_STAGE(PG8_SB(0, 0), b2, voffB); PG8_STAGE(PG8_SB(0, 1), b2 + hstepB, voffB); PG8_STAGE(PG8_SA(0, 0), a2, voffA);
            PG8_WAIT_V(8); PG8_WAIT_L(0); PG8_BAR; PG8_MMA(1, 0, At, B0); PG8_MMA(1, 1, At, B1); PG8_BAR; PG8_SCHED;
            PG8_LDB(B0, 1, 0); PG8_LDB(B1, 1, 1); PG8_SCHED; PG8_LDA(At, 1, 0); PG8_STAGE(PG8_SA(0, 1), a2 + hstepA, voffA);
            PG8_WAIT_V(8); PG8_WAIT_L(0); PG8_BAR; PG8_MMA(0, 0, At, B0); PG8_MMA(0, 1, At, B1); PG8_BAR; PG8_SCHED;
            PG8_LDA(At, 1, 1); PG8_STAGE(PG8_SB(1, 0), b3, voffB); PG8_STAGE(PG8_SB(1, 1), b3 + hstepB, voffB); PG8_STAGE(PG8_SA(1, 0), a3, voffA);
            PG8_WAIT_V(8); PG8_WAIT_L(0); PG8_BAR; PG8_MMA(1, 0, At, B0); PG8_MMA(1, 1, At, B1); PG8_BAR; PG8_SCHED;
            } else {
            PG8_LDB(B0, 0, 0); PG8_SCHED; PG8_LDA(At, 0, 0); PG8_STAGE(PG8_SA(1, 1), a1 + hstepA, voffA);
            PG8_WAIT_L(8); PG8_BAR; PG8_WAIT_L(0); PG8_MMA(0, 0, At, B0); PG8_BAR; PG8_SCHED;
            PG8_LDB(B1, 0, 1); PG8_STAGE(PG8_SB(0, 0), b2, voffB);
            PG8_BAR; PG8_WAIT_L(0); PG8_MMA(0, 1, At, B1); PG8_BAR;
            PG8_LDA(At, 0, 1); PG8_STAGE(PG8_SA(0, 0), a2, voffA);
            PG8_BAR; PG8_WAIT_L(0); PG8_MMA(1, 0, At, B0); PG8_BAR; PG8_SCHED;
            PG8_STAGE(PG8_SB(0, 1), b2 + hstepB, voffB);
            PG8_WAIT_V(6); PG8_BAR; PG8_MMA(1, 1, At, B1); PG8_BAR;
            PG8_LDB(B0, 1, 0); PG8_SCHED; PG8_LDA(At, 1, 0); PG8_STAGE(PG8_SA(0, 1), a2 + hstepA, voffA);
            PG8_WAIT_L(8); PG8_BAR; PG8_WAIT_L(0); PG8_MMA(0, 0, At, B0); PG8_BAR; PG8_SCHED;
            PG8_LDB(B1, 1, 1); PG8_STAGE(PG8_SB(1, 0), b3, voffB);
            PG8_BAR; PG8_WAIT_L(0); PG8_MMA(0, 1, At, B1); PG8_BAR;
            PG8_LDA(At, 1, 1); PG8_STAGE(PG8_SA(1, 0), a3, voffA);
            PG8_BAR; PG8_WAIT_L(0); PG8_MMA(1, 0, At, B0); PG8_BAR; PG8_SCHED;
            PG8_STAGE(PG8_SB(1, 1), b3 + hstepB, voffB);
            PG8_WAIT_V(6); PG8_BAR; PG8_MMA(1, 1, At, B1); PG8_BAR;
            }
        }
        if constexpr (ALIGN_EPI) { if (wr == 0) PG8_BAR; }
        if constexpr (!Epi::AFTER_DRAIN) { const int tlx = lane_id_v(); const int frx = tlx & 15, fqx = (tlx >> 4) & 3;
            E(acc, cur, wr, wc, frx, fqx); S.done(cur); }
        if (!has_next) break;
#pragma unroll
        for (int a = 0; a < 2; ++a)
#pragma unroll
            for (int b = 0; b < 2; ++b)
#pragma unroll
                for (int m = 0; m < 4; ++m)
#pragma unroll
                    for (int n = 0; n < 2; ++n) acc[a][b][m][n] = (f32x4){0.f, 0.f, 0.f, 0.f};
        cur = nxt; cA = nA; cB = nB; ++ui;
        if constexpr (ALIGN_EPI) { if (wr == 1) PG8_BAR; }
    }
    PG8_WAIT_V(0);
    if constexpr (!ALIGN_EPI) { if (wr == 0) PG8_BAR; }
    PG8_BAR;
#undef PG8_SA
#undef PG8_SB
#undef PG8_STAGE
#undef PG8_LDA
#undef PG8_LDB
#undef PG8_MMA
#undef PG8_WAIT_V
#undef PG8_WAIT_L
#undef PG8_BAR
#undef PG8_SCHED
#undef PG8_ABASE
#undef PG8_BBASE
}

template <class Epi, class Sched>
__device__ __forceinline__ void gemm_phase_mix(LAS unsigned char* lds, const Gemm g, const char* A2, const char* B2, int nt2, const Sched& S, const Epi& E, int wv) {
    wv = launder_s(wv);
    const int tid_l = wv * 64 + lane_id_v();
    const int tid = tid_l, wid = wv, lane = tid & 63, wr = wid >> 2, wc = wid & 3, fr = lane & 15, fq = lane >> 4;
    const int nt1 = g.K / BK;
    unsigned voffA[2], voffB[2];
#pragma unroll
    for (int i = 0; i < 2; ++i) { int R, C; stage_rc(tid * 16 + i * 8192, R, C); const int Rb = Epi::PERM ? ((R & ~31) + perm32(R & 31)) : R;
        voffA[i] = (unsigned)(R * g.lda + C) * 2u; voffB[i] = (unsigned)(Rb * g.ldb + C) * 2u; }
    const size_t kstep = (size_t)(BK * 2);
    const size_t hA1 = (size_t)HALF * g.lda * 2, hB1 = (size_t)HALF * g.ldb * 2;
    const unsigned ldsw = (unsigned)wid * 1024u, ldsbase = (unsigned)(size_t)lds;
    const int aoff = lds_byte(wr * 64 + fr, fq * 8), boff = lds_byte(wc * 32 + fr, fq * 8);
#define PG8_SA(b, h) (((b) * 2 + (h)) * HTB)
#define PG8_SB(b, h) ((4 + (b) * 2 + (h)) * HTB)
#define PG8_STAGE(bufoff, gbase, voff) do { _Pragma("unroll") for (int _i = 0; _i < 2; ++_i) \
        asm volatile("s_mov_b32 m0, %2\n\ts_nop 0\n\tglobal_load_lds_dwordx4 %0, %1" :: "v"((voff)[_i]), "s"((const char*)(gbase)), "s"(ldsbase + (unsigned)(bufoff) + ldsw + (unsigned)(_i * 8192)) : "memory", "m0"); } while (0)
#define PG8_LDA(dst, b, h) do { _Pragma("unroll") for (int m = 0; m < 4; ++m) _Pragma("unroll") for (int k = 0; k < 2; ++k) dst[m][k] = *(const LAS bf16x8*)(lds + PG8_SA(b, h) + aoff + m * 2048 + k * 1024); } while (0)
#define PG8_LDB(dst, b, h) do { _Pragma("unroll") for (int n = 0; n < 2; ++n) _Pragma("unroll") for (int k = 0; k < 2; ++k) dst[n][k] = *(const LAS bf16x8*)(lds + PG8_SB(b, h) + boff + n * 2048 + k * 1024); } while (0)
#define PG8_MMA_BF(ai, bj, At, Bt) do { __builtin_amdgcn_s_setprio(1); _Pragma("unroll") for (int m = 0; m < 4; ++m) _Pragma("unroll") for (int n = 0; n < 2; ++n) { \
        _Pragma("unroll") for (int k = 0; k < 2; ++k) acc[ai][bj][m][n] = __builtin_amdgcn_mfma_f32_16x16x32_bf16(Bt[n][k], At[m][k], acc[ai][bj][m][n], 0, 0, 0); } __builtin_amdgcn_s_setprio(0); } while (0)
#define PG8_MMA_F8(ai, bj, At, Bt) do { __builtin_amdgcn_s_setprio(1); _Pragma("unroll") for (int m = 0; m < 4; ++m) _Pragma("unroll") for (int n = 0; n < 2; ++n) { \
        acc[ai][bj][m][n] = __builtin_amdgcn_mfma_scale_f32_16x16x128_f8f6f4(pk8(Bt[n][0], Bt[n][1]), pk8(At[m][0], At[m][1]), acc[ai][bj][m][n], 0, 0, 0, 0x7c7c7c7c, 0, 0x7c7c7c7c); } __builtin_amdgcn_s_setprio(0); } while (0)
#define PG8_WAIT_V(n) asm volatile("s_waitcnt vmcnt(" #n ")" ::: "memory")
#define PG8_WAIT_L(n) asm volatile("s_waitcnt lgkmcnt(" #n ")" ::: "memory")
#define PG8_BAR __builtin_amdgcn_s_barrier()
#define PG8_SCHED __builtin_amdgcn_sched_barrier(0)
#define PG8_ITER(MMA) do { \
            PG8_LDB(B0, 0, 0); PG8_LDB(B1, 0, 1); PG8_SCHED; PG8_LDA(At, 0, 0); PG8_STAGE(PG8_SA(1, 1), a1 + hA1, voffA); \
            PG8_WAIT_V(8); PG8_WAIT_L(0); PG8_BAR; MMA(0, 0, At, B0); MMA(0, 1, At, B1); PG8_BAR; PG8_SCHED; \
            PG8_LDA(At, 0, 1); PG8_STAGE(PG8_SB(0, 0), b2, voffB); PG8_STAGE(PG8_SB(0, 1), b2 + hB1, voffB); PG8_STAGE(PG8_SA(0, 0), a2, voffA); \
            PG8_WAIT_V(8); PG8_WAIT_L(0); PG8_BAR; MMA(1, 0, At, B0); MMA(1, 1, At, B1); PG8_BAR; PG8_SCHED; \
            PG8_LDB(B0, 1, 0); PG8_LDB(B1, 1, 1); PG8_SCHED; PG8_LDA(At, 1, 0); PG8_STAGE(PG8_SA(0, 1), a2 + hA1, voffA); \
            PG8_WAIT_V(8); PG8_WAIT_L(0); PG8_BAR; MMA(0, 0, At, B0); MMA(0, 1, At, B1); PG8_BAR; PG8_SCHED; \
            PG8_LDA(At, 1, 1); PG8_STAGE(PG8_SB(1, 0), b3, voffB); PG8_STAGE(PG8_SB(1, 1), b3 + hB1, voffB); PG8_STAGE(PG8_SA(1, 0), a3, voffA); \
            PG8_WAIT_V(8); PG8_WAIT_L(0); PG8_BAR; MMA(1, 0, At, B0); MMA(1, 1, At, B1); PG8_BAR; PG8_SCHED; } while (0)
    Unit cur, nxt; int ui = 0;
    if (!S.next(0, cur)) return;
    f32x4 acc[2][2][4][2];
#pragma unroll
    for (int a = 0; a < 2; ++a)
#pragma unroll
        for (int b = 0; b < 2; ++b)
#pragma unroll
            for (int m = 0; m < 4; ++m)
#pragma unroll
                for (int n = 0; n < 2; ++n) acc[a][b][m][n] = (f32x4){0.f, 0.f, 0.f, 0.f};
    bf16x8 At[4][2], B0[2][2], B1[2][2];
    const char* cA = (const char*)g.A + (size_t)cur.pm * (2 * hA1); const char* cB = (const char*)g.Bt + (size_t)cur.pn * (2 * hB1);
    PG8_STAGE(PG8_SB(0, 0), cB, voffB); PG8_STAGE(PG8_SB(0, 1), cB + hB1, voffB); PG8_STAGE(PG8_SA(0, 0), cA, voffA); PG8_STAGE(PG8_SA(0, 1), cA + hA1, voffA);
    if (wr == 1) PG8_BAR;
    PG8_WAIT_V(2); PG8_BAR;
    PG8_STAGE(PG8_SB(1, 0), cB + kstep, voffB); PG8_STAGE(PG8_SA(1, 0), cA + kstep, voffA); PG8_STAGE(PG8_SB(1, 1), cB + hB1 + kstep, voffB);
    PG8_WAIT_V(6); PG8_BAR;
    for (;;) {
        const bool has_next = S.next(ui + 1, nxt);
        const char* nA = has_next ? (const char*)g.A + (size_t)nxt.pm * (2 * hA1) : cA; const char* nB = has_next ? (const char*)g.Bt + (size_t)nxt.pn * (2 * hB1) : cB;
        const char* cA2 = A2 + (size_t)cur.pm * (2 * hA1); const char* cB2 = B2 + (size_t)cur.pn * (2 * hB1);
        for (int t = 0; t < nt1; t += 2) {
            const bool sw = (t == nt1 - 2);
            const char* a1 = cA + (size_t)(t + 1) * kstep;
            const char* a2 = sw ? cA2 : cA + (size_t)(t + 2) * kstep; const char* b2 = sw ? cB2 : cB + (size_t)(t + 2) * kstep;
            const char* a3 = a2 + kstep; const char* b3 = b2 + kstep;
            PG8_ITER(PG8_MMA_BF);
        }
        for (int t = 0; t < nt2; t += 2) {
            const bool sw = (t == nt2 - 2);
            const char* a1 = cA2 + (size_t)(t + 1) * kstep;
            const char* a2 = sw ? nA : cA2 + (size_t)(t + 2) * kstep; const char* b2 = sw ? nB : cB2 + (size_t)(t + 2) * kstep;
            const char* a3 = a2 + kstep; const char* b3 = b2 + kstep;
            PG8_ITER(PG8_MMA_F8);
        }
        if (wr == 0) PG8_BAR;
        { const int tlx = lane_id_v(); const int frx = tlx & 15, fqx = (tlx >> 4) & 3; E(acc, cur, wr, wc, frx, fqx); }
        if (!has_next) break;
#pragma unroll
        for (int a = 0; a < 2; ++a)
#pragma unroll
            for (int b = 0; b < 2; ++b)
#pragma unroll
                for (int m = 0; m < 4; ++m)
#pragma unroll
                    for (int n = 0; n < 2; ++n) acc[a][b][m][n] = (f32x4){0.f, 0.f, 0.f, 0.f};
        cur = nxt; cA = nA; cB = nB; ++ui;
        if (wr == 1) PG8_BAR;
    }
    PG8_WAIT_V(0);
    PG8_BAR;
    (void)fr; (void)fq;
#undef PG8_SA
#undef PG8_SB
#undef PG8_STAGE
#undef PG8_LDA
#undef PG8_LDB
#undef PG8_MMA_BF
#undef PG8_MMA_F8
#undef PG8_WAIT_V
#undef PG8_WAIT_L
#undef PG8_BAR
#undef PG8_SCHED
#undef PG8_ITER
}
}

#define XB_TMO      128
#define XB_XCNT(j)  (256  + 64 * (j))
#define XB_XSUB(j)  (1280 + 64 * (j))
#define XB_XGEN(j)  (2304 + 64 * (j))
#define XB_TOP      3328
#define XB_TOPGEN   3392
#define XCD_BAR_WORDS 3456
#define XB_SPIN_CAP (1u << 18)

__device__ __forceinline__ unsigned xb_ld(unsigned* p)              { return __hip_atomic_load(p, __ATOMIC_RELAXED, __HIP_MEMORY_SCOPE_AGENT); }
__device__ __forceinline__ unsigned xb_add(unsigned* p, unsigned v) { return __hip_atomic_fetch_add(p, v, __ATOMIC_RELAXED, __HIP_MEMORY_SCOPE_AGENT); }
__device__ __forceinline__ unsigned xb_xcc_id() { return (unsigned)__builtin_amdgcn_s_getreg((3 << 11) | 20) & 0xFu; }
#define XB_SPIN(cond, bar) do { unsigned _sp = 0; while (cond) { __builtin_amdgcn_s_sleep(1); \
    if ((++_sp & 255u) == 0u) { if (xb_ld(&(bar)[XB_TMO])) break; if (_sp > XB_SPIN_CAP) { atomicAdd(&(bar)[XB_TMO], 1u); break; } } } } while (0)

struct XcdBarrier {
    unsigned* bar; unsigned x;
    volatile LAS unsigned* st;
};
__device__ __forceinline__ XcdBarrier xcd_barrier_post(unsigned* bar, volatile LAS unsigned* st, int wave) {
    XcdBarrier b; b.bar = bar; b.x = xb_xcc_id(); b.st = st;
    if (wave == 0 && lane_id_v() == 0) (void)xb_add(&bar[XB_XCNT(b.x)], 1u);
    return b;
}
__device__ __forceinline__ void xcd_barrier_complete(unsigned* bar, unsigned x, unsigned& nloc, unsigned& nx) {
    const unsigned G = gridDim.x * gridDim.y * gridDim.z;
    unsigned sum, cnt, mine, sp = 0u;
    for (;;) {
        sum = 0u; cnt = 0u; mine = 0u;
#pragma unroll
        for (unsigned j = 0; j < 16; ++j) { const unsigned c = xb_ld(&bar[XB_XCNT(j)]); sum += c; cnt += (c > 0u) ? 1u : 0u; mine = (j == x) ? c : mine; }
        if (sum == G) break;
        __builtin_amdgcn_s_sleep(1);
        if ((++sp & 255u) == 0u) { if (xb_ld(&bar[XB_TMO])) break; if (sp > XB_SPIN_CAP) { atomicAdd(&bar[XB_TMO], 1u); break; } }
    }
    nloc = mine > 0u ? mine : 1u; nx = cnt > 0u ? cnt : 1u;
}
__device__ __forceinline__ void xcd_barrier(const XcdBarrier& b, int wave) {
    asm volatile("s_waitcnt vmcnt(0)" ::: "memory");
    __syncthreads();
    if (wave == 0 && lane_id_v() == 0) {
        unsigned* bar = b.bar; asm volatile("" : "+s"(bar));
        const unsigned bx = xb_xcc_id();
        __builtin_amdgcn_s_waitcnt(0);
        unsigned nloc = b.st[0], nx = b.st[1];
        if (nloc == 0u) { xcd_barrier_complete(bar, bx, nloc, nx); b.st[0] = nloc; b.st[1] = nx; }
        const unsigned old = xb_add(&bar[XB_XSUB(bx)], 1u);
        const unsigned gen = old / nloc;
        if (old + 1u == (gen + 1u) * nloc) {
            __builtin_amdgcn_fence(__ATOMIC_RELEASE, "agent");
            asm volatile("s_waitcnt vmcnt(0)" ::: "memory");
            const unsigned og = xb_add(&bar[XB_TOP], 1u);
            const unsigned tg = og / nx;
            if (og + 1u == (tg + 1u) * nx) xb_add(&bar[XB_TOPGEN], 1u);
            else XB_SPIN(xb_ld(&bar[XB_TOPGEN]) == tg, bar);
            __builtin_amdgcn_fence(__ATOMIC_ACQUIRE, "agent");
            xb_add(&bar[XB_XGEN(bx)], 1u);
            asm volatile("s_waitcnt vmcnt(0)" ::: "memory");
        } else {
            XB_SPIN(xb_ld(&bar[XB_XGEN(bx)]) == gen, bar);
            __builtin_amdgcn_fence(__ATOMIC_ACQUIRE, "agent");
            asm volatile("s_waitcnt vmcnt(0)" ::: "memory");
        }
    }
    __syncthreads();
}

constexpr int NWAVES = 8;
struct Frame {
    LAS unsigned char* lds;
    int tid, lane, wave, vcu, G;
};
#define FRESH(Fx) Frame Fx = F; { const int t_ = F.wave * 64 + lane_id_v(); Fx.tid = t_; Fx.lane = t_ & 63; }
struct Args {
    const float* x; const float* meta; const float* n1g; const float* w_in; const float* pool_w; const float* pool_scale; const float* w_out;
    const float* n2g; const float* w_up; const float* conv_w; const float* conv_b; const float* w_down; const float* final_g;
    float* out; unsigned char* ws; int ph_lo, ph_hi;
};
typedef const Args __attribute__((address_space(4))) CArgs;
__device__ __forceinline__ CArgs* args_ptr() { CArgs* p = (CArgs*)__builtin_amdgcn_kernarg_segment_ptr(); asm volatile("" : "+s"(p)); return p; }

constexpr int TP = 136;
__device__ __forceinline__ bf16x4 tr_read(const LAS unsigned char* p) { return __builtin_amdgcn_ds_read_tr16_b64_v4i16((LAS bf16x4*)p); }
struct TItem { const float* W; const float* ksc; bf16_t* WT; unsigned char* WT8; int ldw; unsigned ldo, ldo8; int k0, n0, nd0; int f8; };
__device__ __forceinline__ void t_load(const TItem& t, f32x4 (&v)[16], float (&ks)[16], int lane) {
    const int g = lane >> 4, i15 = lane & 15;
#pragma unroll
    for (int j = 0; j < 16; ++j) ks[j] = t.ksc ? t.ksc[t.k0 + 4 * j + g] : 1.0f;
#pragma unroll
    for (int j = 0; j < 16; ++j) v[j] = __builtin_nontemporal_load((const f32x4*)(t.W + (size_t)(t.k0 + 4 * j + g) * t.ldw + t.n0 + 4 * i15));
}
__device__ __forceinline__ void t_store(const TItem& t, const f32x4 (&v)[16], const float (&ks)[16], LAS unsigned char* scr, int lane) {
    const int g = lane >> 4, i15 = lane & 15;
#pragma unroll
    for (int j = 0; j < 16; ++j) {
        const float sc = ks[j];
        u32x2 w; w.x = cvt_pk_bf16(v[j][0] * sc, v[j][1] * sc); w.y = cvt_pk_bf16(v[j][2] * sc, v[j][3] * sc);
        *(LAS u32x2*)(scr + (4 * j + g) * TP + 8 * i15) = w;
    }
    LDS_WAIT(); asm volatile("" ::: "memory");
    const int qp = i15 >> 2, pp = lane & 3, Qa = 4 * g + pp, ca = Qa & 7, nqa = Qa >> 3;
    const int Qr = lane >> 2, cr = Qr & 7, nqr = Qr >> 3;
    const LAS unsigned char* ra = scr + (8 * ca + qp) * TP + 8 * nqa;
    bf16_t* wp = t.WT + (size_t)(t.nd0 + 4 * nqr + pp) * t.ldo + t.k0 + 8 * cr;
    if (t.f8) {
        unsigned char* wp8 = t.WT8 + (size_t)(t.nd0 + 4 * nqr + pp) * t.ldo8 + t.k0 + 8 * cr;
#pragma unroll
        for (int pass = 0; pass < 8; ++pass) {
            const u32x2 lo = __builtin_bit_cast(u32x2, tr_read(ra + 16 * pass)), hi = __builtin_bit_cast(u32x2, tr_read(ra + 4 * TP + 16 * pass));
            u32x2 o; o.x = pk4_fp8(bf_lo(lo.x) * W8_SCALE, bf_hi(lo.x) * W8_SCALE, bf_lo(lo.y) * W8_SCALE, bf_hi(lo.y) * W8_SCALE);
            o.y = pk4_fp8(bf_lo(hi.x) * W8_SCALE, bf_hi(hi.x) * W8_SCALE, bf_lo(hi.y) * W8_SCALE, bf_hi(hi.y) * W8_SCALE);
            __builtin_nontemporal_store(o, (u32x2*)(wp8 + (size_t)(8 * pass) * t.ldo8));
        }
    }
    if (t.f8 != 1) {
#pragma unroll
    for (int pass = 0; pass < 8; ++pass) {
        const bf16x4 lo = tr_read(ra + 16 * pass), hi = tr_read(ra + 4 * TP + 16 * pass);
        __builtin_nontemporal_store(__builtin_shufflevector(lo, hi, 0, 1, 2, 3, 4, 5, 6, 7), (bf16x8*)(wp + (size_t)(8 * pass) * t.ldo));
    }
    }
    LDS_WAIT(); asm volatile("" ::: "memory");
}
constexpr int T_IN = (D / 256) * (INC / 256), T_OT = (RW / 256) * (D / 256), T_UP = (D / 256) * (UPC / 256), T_DN = (DFF / 256) * (D / 256);
constexpr int T_LAYER = T_IN + 2 * T_OT + T_UP + T_DN;
__device__ __forceinline__ TItem t_decode(CArgs& a, int T, int w, int sub) {
    unsigned char* ws = a.ws; TItem t; t.f8 = 0; t.WT8 = nullptr; t.ldo8 = 0;
    int l = 0, kind = 0, r = T;
    if (r < T_IN) { kind = 0; }
    else if ((r -= T_IN) < 4 * T_OT) { l = r / (2 * T_OT); r -= l * 2 * T_OT; kind = 1; if (r >= T_OT) { kind = 2; r -= T_OT; } }
    else if ((r -= 4 * T_OT) < T_UP) { kind = 3; }
    else if ((r -= T_UP) < T_DN) { kind = 4; }
    else if ((r -= T_DN) < T_IN) { kind = 0; l = 1; }
    else if ((r -= T_IN) < T_UP) { kind = 3; l = 1; }
    else { r -= T_UP; kind = 4; l = 1; }
    const int kw = 128 * (w >> 2) + 64 * sub, nw = 64 * (w & 3);
    if (kind == 0) { const int nb = INC / 256; t.W = a.w_in + (size_t)l * D * INC; t.ldw = INC; t.ksc = a.n1g + l * D; t.WT = (bf16_t*)(ws + WS_WIN) + (size_t)l * INC * D; t.ldo = D; t.k0 = 256 * (r / nb) + kw; t.n0 = t.nd0 = 256 * (r % nb) + nw; return t; }
    if (kind == 1) { const int nb = D / 256; t.W = a.w_out + (size_t)l * D * D; t.ldw = D; t.ksc = nullptr; t.WT = (bf16_t*)(ws + WS_WC) + (size_t)l * D * D; t.ldo = D; t.k0 = 256 * (r / nb) + kw; t.n0 = t.nd0 = 256 * (r % nb) + nw; return t; }
    if (kind == 2) { const int nb = D / 256; t.W = a.w_out + (size_t)l * D * D + (size_t)RW * D; t.ldw = D; t.ksc = nullptr; t.WT = (bf16_t*)(ws + WS_WB) + (size_t)l * D * PW; t.ldo = PW; t.k0 = 256 * (r / nb) + kw; t.n0 = t.nd0 = 256 * (r % nb) + nw; return t; }
    if (kind == 3) { const int nb = UPC / 256, n0 = 256 * (r % nb) + nw, nn = n0 < DFF ? n0 : n0 - DFF;
        t.W = a.w_up + (size_t)l * D * UPC; t.ldw = UPC; t.ksc = a.n2g + l * D; t.WT = (bf16_t*)(ws + WS_WUP) + (size_t)l * UPC * D; t.ldo = D; t.k0 = 256 * (r / nb) + kw; t.n0 = n0; t.nd0 = 256 * (nn / 128) + (nn % 128) + (n0 < DFF ? 0 : 128); return t; }
    { const int nb = D / 256; t.W = a.w_down + (size_t)l * DFF * D; t.ldw = D; t.ksc = nullptr; t.WT = (bf16_t*)(ws + WS_WDN) + (size_t)l * D * DFF; t.ldo = DFF;
      if (l == NLAYER - 1) { t.f8 = 1; t.WT8 = ws + WS_WDN8; t.ldo8 = DFF; }
      else if (256 * (r / nb) >= K1MIX) { t.f8 = 2; t.WT8 = ws + WS_WDN8L0; t.ldo8 = 2 * DFF; }
      t.k0 = 256 * (r / nb) + kw; t.n0 = t.nd0 = 256 * (r % nb) + nw; return t; }
}
constexpr int T_EARLY = T_IN + 4 * T_OT, T_L0 = T_EARLY + T_UP + T_DN, T_ALL = NLAYER * T_LAYER;
__device__ __forceinline__ void conv_tiles(const Frame& F0, CArgs& a, int j0, int j1) {
    Frame F = F0; { const int t_ = F0.wave * 64 + lane_id_v(); F.tid = t_; F.lane = t_ & 63; }
    LAS unsigned char* scr = F.lds + F.wave * 16384;
    {
        int T = j0 + F.vcu, sub = 0;
        if (T < j1) {
            TItem cur = t_decode(a, T, F.wave, 0); f32x4 va[16], vb[16]; float ka[16], kb[16];
            t_load(cur, va, ka, F.lane);
            for (;;) {
                const int Tn = sub ? T + F.G : T, subn = sub ^ 1; const bool more = Tn < j1;
                TItem nxt = cur; if (more) { nxt = t_decode(a, Tn, F.wave, subn); t_load(nxt, vb, kb, F.lane); }
                t_store(cur, va, ka, scr, F.lane);
                if (!more) break;
#pragma unroll
                for (int j = 0; j < 16; ++j) { va[j] = vb[j]; ka[j] = kb[j]; }
                cur = nxt; T = Tn; sub = subn;
            }
        }
    }
    __syncthreads();
}
__device__ __forceinline__ void pools_build(const Frame& F, CArgs& a) {
    unsigned char* ws = a.ws;
    {
        const int gt = F.vcu * (NWAVES * 64) + F.wave * 64 + lane_id_v(), NT = F.G * NWAVES * 64;
        bf16_t* ps = (bf16_t*)(ws + WS_POOLS);
        for (int i = gt; i < NLAYER * 2048 * 512 / 8; i += NT) {
            const int e = i * 8, l = e / (2048 * 512), rem = e % (2048 * 512), g = rem / (512 * 512), d = rem % 512;
            const f32x4 w0 = *(const f32x4*)(a.pool_w + e), w1 = *(const f32x4*)(a.pool_w + e + 4);
            const f32x4 s0 = *(const f32x4*)(a.pool_scale + l * PW + g * 512 + d), s1 = *(const f32x4*)(a.pool_scale + l * PW + g * 512 + d + 4);
            u32x4 o; o.x = cvt_pk_bf16(w0[0] * s0[0], w0[1] * s0[1]); o.y = cvt_pk_bf16(w0[2] * s0[2], w0[3] * s0[3]); o.z = cvt_pk_bf16(w1[0] * s1[0], w1[1] * s1[1]); o.w = cvt_pk_bf16(w1[2] * s1[2], w1[3] * s1[3]);
            *(u32x4*)(ps + e) = o;
        }
    }
}
__device__ __forceinline__ void p0_prologue(Frame& F0, CArgs& a) {
    Frame F = F0; { const int t_ = F0.wave * 64 + lane_id_v(); F.tid = t_; F.lane = t_ & 63; }
    const int gw = F.vcu * NWAVES + F.wave, NGW = F.G * NWAVES;
    unsigned char* ws = a.ws;
    conv_tiles(F0, a, 0, T_IN);
    {
        bf16_t* hb = (bf16_t*)(ws + WS_HB); ssq_t* ss0 = (ssq_t*)((unsigned*)(ws + WS_CTL) + CW_SS);
        for (int R = gw; R < MP; R += NGW) {
            const float* src = R < MMAIN ? a.x + (size_t)R * D : (R >= METAR0 ? a.meta + (size_t)(R - METAR0) * D : nullptr);
            float s = 0.f;
            f32x4 xv[16];
#pragma unroll
            for (int j = 0; j < 16; ++j) xv[j] = *(const f32x4*)((src ? src : a.x) + 4 * F.lane + 256 * j);
            asm volatile("" : "+v"(xv[0]), "+v"(xv[1]), "+v"(xv[2]), "+v"(xv[3]), "+v"(xv[4]), "+v"(xv[5]), "+v"(xv[6]), "+v"(xv[7]), "+v"(xv[8]), "+v"(xv[9]), "+v"(xv[10]), "+v"(xv[11]), "+v"(xv[12]), "+v"(xv[13]), "+v"(xv[14]), "+v"(xv[15]));
#pragma unroll
            for (int j = 0; j < 16; ++j) {
                f32x4 v = xv[j]; if (!src) v = (f32x4){0.f, 0.f, 0.f, 0.f};
                s += (v[0] * v[0] + v[1] * v[1]) + (v[2] * v[2] + v[3] * v[3]);
                u32x2 w; w.x = cvt_pk_bf16(v[0], v[1]); w.y = cvt_pk_bf16(v[2], v[3]);
                *(u32x2*)(hb + (size_t)R * D + 4 * F.lane + 256 * j) = w;
            }
            s = wave_sum(s);
            if (F.lane == 0) ss0[R] = (ssq_t)(s * SSQ_SCALE + 0.5f);
        }
    }
}

constexpr int RSLOT = 32768;
#define RT_WAIT_V(n) asm volatile("s_waitcnt vmcnt(" #n ")" ::: "memory")
__device__ __forceinline__ unsigned lds_addr(const LAS void* p) { return (unsigned)(size_t)p; }
__device__ __forceinline__ void glds16(const void* gsrc, unsigned lds_dst) {
    unsigned keep;
    asm volatile("s_mov_b32 %0, m0\n\ts_mov_b32 m0, %2\n\ts_nop 0\n\tglobal_load_lds_dwordx4 %1, off\n\ts_mov_b32 m0, %0" : "=&s"(keep) : "v"(gsrc), "s"(lds_dst) : "memory");
}
#define RT_BAR() do { asm volatile("s_waitcnt lgkmcnt(0)\n\ts_barrier" ::: "memory"); } while (0)
__device__ __forceinline__ bf16x8 cat4(bf16x4 a, bf16x4 b) { return __builtin_shufflevector(a, b, 0, 1, 2, 3, 4, 5, 6, 7); }

__device__ __forceinline__ void kv_unit(Frame& F, const bf16_t* proj, float* outp, int base_row, int h) {
    const int tid_l = F.wave * 64 + lane_id_v();
    const int tid = tid_l, lane = tid_l & 63, w = F.wave, wd = w >> 1, we = w & 1, g = lane >> 4, q = (lane & 15) >> 2, p = lane & 3;
    const float lg = head_lg(h), c255 = __builtin_amdgcn_exp2f(255.0f * lg);
    const bf16_t* Kp = proj + (size_t)base_row * INC + RW + h * DH;
    const bf16_t* Vp = proj + (size_t)base_row * INC + 2 * RW + h * DH;
    unsigned soff[2];
#pragma unroll
    for (int i = 0; i < 2; ++i) { const int id = tid + 512 * i, row = id >> 5, sc = id & 31; soff[i] = (unsigned)(row * INC + 8 * (sc ^ (2 * (row & 7)))) * 2u; }
    const unsigned ring = __builtin_amdgcn_readfirstlane(lds_addr(F.lds) + (unsigned)w * 1024u);
#define KV_ISSUE(cb) do { const unsigned sl_ = ring + (unsigned)((cb) & 3) * RSLOT; const char* kp_ = (const char*)(Kp + (size_t)(32 * (cb)) * INC); const char* vp_ = (const char*)(Vp + (size_t)(32 * (cb)) * INC); \
        glds16(kp_ + soff[0], sl_); glds16(kp_ + soff[1], sl_ + 8192); glds16(vp_ + soff[0], sl_ + 16384); glds16(vp_ + soff[1], sl_ + 16384 + 8192); } while (0)
    const int rr = 4 * g + q, swz0 = 2 * (rr & 7), ph = p >> 1;
    const unsigned rbase = (unsigned)(rr * 512 + 8 * (p & 1));
    f32x4 acc[4][8];
#pragma unroll
    for (int i = 0; i < 4; ++i)
#pragma unroll
        for (int j = 0; j < 8; ++j) acc[i][j] = (f32x4){0.f, 0.f, 0.f, 0.f};
    KV_ISSUE(0); KV_ISSUE(1); KV_ISSUE(2);
    for (int cb = 0; cb < 8; ++cb) {
        if (cb + 2 < 8) RT_WAIT_V(8); else if (cb + 1 < 8) RT_WAIT_V(4); else RT_WAIT_V(0);
        RT_BAR();
        if (cb + 3 < 8) KV_ISSUE(cb + 3);
        int swz = swz0; asm volatile("" : "+v"(swz));
        const LAS unsigned char* kb = F.lds + (cb & 3) * RSLOT; const LAS unsigned char* vb = kb + 16384;
        bf16x8 af[4], bfr[8];
#pragma unroll
        for (int dt = 0; dt < 4; ++dt) {
            const unsigned co = (unsigned)((((2 * (4 * wd + dt)) ^ swz) | ph) * 16);
            const bf16x4 lo = tr_read(kb + rbase + co), hi = tr_read(kb + rbase + 16 * 512 + co);
            af[dt] = cat4(lo, hi);
        }
#pragma unroll
        for (int et = 0; et < 8; ++et) {
            const unsigned co = (unsigned)((((2 * (8 * we + et)) ^ swz) | ph) * 16);
            bfr[et] = cat4(tr_read(vb + rbase + co), tr_read(vb + rbase + 16 * 512 + co));
        }
#pragma unroll
        for (int dt = 0; dt < 4; ++dt)
#pragma unroll
            for (int et = 0; et < 8; ++et) acc[dt][et] = __builtin_amdgcn_mfma_f32_16x16x32_bf16(af[dt], bfr[et], acc[dt][et], 0, 0, 0);
    }
#undef KV_ISSUE
#pragma unroll
    for (int dt = 0; dt < 4; ++dt)
#pragma unroll
        for (int et = 0; et < 8; ++et) *(f32x4*)(outp + (size_t)(16 * (8 * we + et) + (lane & 15)) * DH + 16 * (4 * wd + dt) + 4 * g) = acc[dt][et] * c255;
    asm volatile("s_waitcnt lgkmcnt(0)" ::: "memory"); RT_BAR();
}

__device__ __forceinline__ void ret_unit(Frame& F, const bf16_t* proj, const bf16_t* St, bf16_t* cat, int base_row, int h, int half, bool has_state, int sb0) {
    const int tid_l = F.wave * 64 + lane_id_v();
    const int tid = tid_l, lane = tid_l & 63, w = F.wave, g = lane >> 4, fr = lane & 15, q = fr >> 2, p = lane & 3;
    const float lg = head_lg(h);
    const int c0 = 128 * half + 16 * w, cl = c0 + fr, R = base_row + cl;
    const bf16_t* Kp = proj + (size_t)base_row * INC + RW + h * DH;
    const bf16_t* Vp = proj + (size_t)base_row * INC + 2 * RW + h * DH;
    bf16x8 qf[8];
#pragma unroll
    for (int ks = 0; ks < 8; ++ks) qf[ks] = *(const bf16x8*)(proj + (size_t)R * INC + h * DH + 32 * ks + 8 * g);
    f32x4 acc[16];
#pragma unroll
    for (int i = 0; i < 16; ++i) acc[i] = (f32x4){0.f, 0.f, 0.f, 0.f};
    const int nst = has_state ? 8 : 0, nsb = 4 * half + 4;
    const int my_sb_max = (c0 + 15) >> 5;
    unsigned soS[2], soK[2], soV[2];
#pragma unroll
    for (int i = 0; i < 2; ++i) { const int id = tid + 512 * i; soS[i] = (unsigned)((id >> 2) * DH + 8 * (id & 3)) * 2u;
        const int row = id >> 5, sc = id & 31; soK[i] = (unsigned)(row * INC + 8 * (sc ^ (row & 15))) * 2u; soV[i] = (unsigned)(row * INC + 8 * (sc ^ (2 * (row & 7)))) * 2u; }
    const unsigned ring = __builtin_amdgcn_readfirstlane(lds_addr(F.lds) + (unsigned)w * 1024u);
#define RT_ISSUE_S(s) do { const unsigned sl_ = ring + (unsigned)((s) % 3) * RSLOT; const char* sp_ = (const char*)(St + 32 * (s)); glds16(sp_ + soS[0], sl_); glds16(sp_ + soS[1], sl_ + 8192); } while (0)
#define RT_ISSUE_KV(s, sb) do { const unsigned sl_ = ring + (unsigned)((s) % 3) * RSLOT; const char* kp_ = (const char*)(Kp + (size_t)(32 * (sb)) * INC); const char* vp_ = (const char*)(Vp + (size_t)(32 * (sb)) * INC); \
        glds16(kp_ + soK[0], sl_); glds16(kp_ + soK[1], sl_ + 8192); glds16(vp_ + soV[0], sl_ + 16384); glds16(vp_ + soV[1], sl_ + 16384 + 8192); } while (0)
    const int rr = 4 * g + q, swz0 = 2 * (rr & 7), ph = p >> 1;
    const unsigned vbase = (unsigned)(16384 + rr * 512 + 8 * (p & 1));
    if (has_state) { RT_ISSUE_S(0); RT_ISSUE_S(1); } else { RT_ISSUE_KV(0, sb0); if (sb0 + 1 < nsb) RT_ISSUE_KV(1, sb0 + 1); }
#pragma unroll
    for (int ks = 0; ks < 8; ++ks) asm volatile("" : "+v"(qf[ks]));
    if (has_state) {
#pragma unroll
        for (int s = 0; s < 8; ++s) {
            if (s + 1 < 8) RT_WAIT_V(2); else RT_WAIT_V(4);
            RT_BAR();
            if (s + 2 < 8) RT_ISSUE_S(s + 2); else RT_ISSUE_KV(s + 2, sb0 + s + 2 - 8);
            const LAS unsigned char* buf = F.lds + (s % 3) * RSLOT;
#pragma unroll
            for (int eh = 0; eh < 2; ++eh) {
                bf16x8 a[8];
#pragma unroll
                for (int i = 0; i < 8; ++i) a[i] = *(const LAS bf16x8*)(buf + (16 * (8 * eh + i) + fr) * 64 + g * 16);
#pragma unroll
                for (int i = 0; i < 8; ++i) acc[8 * eh + i] = __builtin_amdgcn_mfma_f32_16x16x32_bf16(a[i], qf[s], acc[8 * eh + i], 0, 0, 0);
            }
        }
        const float qd = __builtin_amdgcn_exp2f(lg);
#pragma unroll
        for (int et = 0; et < 16; ++et) acc[et] *= qd;
    }
    for (int sb = sb0; sb < nsb; ++sb) {
        const int s = nst + sb - sb0;
        if (sb + 1 < nsb) RT_WAIT_V(4); else RT_WAIT_V(0);
        RT_BAR();
        if (sb + 2 < nsb) RT_ISSUE_KV(s + 2, sb + 2);
        const LAS unsigned char* buf = F.lds + (s % 3) * RSLOT;
        if (sb <= my_sb_max) {
            int swz = swz0, frx = fr; asm volatile("" : "+v"(swz), "+v"(frx));
            f32x4 sa[2];
#pragma unroll
            for (int st = 0; st < 2; ++st) {
                bf16x8 a[8];
#pragma unroll
                for (int ks = 0; ks < 8; ++ks) a[ks] = *(const LAS bf16x8*)(buf + (16 * st + fr) * 512 + (((4 * ks + g) ^ frx) * 16));
                sa[st] = (f32x4){0.f, 0.f, 0.f, 0.f};
#pragma unroll
                for (int ks = 0; ks < 8; ++ks) sa[st] = __builtin_amdgcn_mfma_f32_16x16x32_bf16(a[ks], qf[ks], sa[st], 0, 0, 0);
            }
            float pv[8];
#pragma unroll
            for (int st = 0; st < 2; ++st)
#pragma unroll
                for (int r = 0; r < 4; ++r) {
                    const int dl = cl - (32 * sb + 16 * st + 4 * g + r);
                    pv[4 * st + r] = dl >= 0 ? sa[st][r] : 0.f;
                }
            u32x4 pu; pu.x = cvt_pk_bf16(pv[0], pv[1]); pu.y = cvt_pk_bf16(pv[2], pv[3]); pu.z = cvt_pk_bf16(pv[4], pv[5]); pu.w = cvt_pk_bf16(pv[6], pv[7]);
            const bf16x8 pf = __builtin_bit_cast(bf16x8, pu);
#pragma unroll
            for (int eq = 0; eq < 4; ++eq) {
                bf16x8 a[4];
#pragma unroll
                for (int i = 0; i < 4; ++i) { const unsigned co = (unsigned)((((2 * (4 * eq + i)) ^ swz) | ph) * 16); a[i] = cat4(tr_read(buf + vbase + co), tr_read(buf + vbase + 16 * 512 + co)); }
#pragma unroll
                for (int i = 0; i < 4; ++i) acc[4 * eq + i] = __builtin_amdgcn_mfma_f32_16x16x32_bf16(a[i], pf, acc[4 * eq + i], 0, 0, 0);
            }
        }
    }
#undef RT_ISSUE_S
#undef RT_ISSUE_KV
    const bf16_t* sgp = proj + (size_t)R * INC + 3 * RW + h * DH + 4 * g;
    u32x2 sgv[16];
#pragma unroll
    for (int et = 0; et < 16; ++et) sgv[et] = *(const u32x2*)(sgp + 16 * et);
    float ssq = 0.f;
#pragma unroll
    for (int et = 0; et < 16; ++et) ssq += (acc[et][0] * acc[et][0] + acc[et][1] * acc[et][1]) + (acc[et][2] * acc[et][2] + acc[et][3] * acc[et][3]);
    ssq += shx(ssq, 16); ssq += shx(ssq, 32);
    const float rn = __builtin_amdgcn_rsqf(ssq * (1.0f / DH) + EPS);
    bf16_t* op = cat + (size_t)R * D + h * DH + 4 * g;
    asm volatile("" : "+v"(sgv[0]), "+v"(sgv[1]), "+v"(sgv[2]), "+v"(sgv[3]), "+v"(sgv[4]), "+v"(sgv[5]), "+v"(sgv[6]), "+v"(sgv[7]), "+v"(sgv[8]), "+v"(sgv[9]), "+v"(sgv[10]), "+v"(sgv[11]), "+v"(sgv[12]), "+v"(sgv[13]), "+v"(sgv[14]), "+v"(sgv[15]));
#pragma unroll
    for (int et = 0; et < 16; ++et) {
        const u32x2 sg = sgv[et];
        u32x2 o; o.x = cvt_pk_bf16(acc[et][0] * rn * bf_lo(sg.x), acc[et][1] * rn * bf_hi(sg.x)); o.y = cvt_pk_bf16(acc[et][2] * rn * bf_lo(sg.y), acc[et][3] * rn * bf_hi(sg.y));
        *(u32x2*)(op + 16 * et) = o;
    }
    asm volatile("s_waitcnt lgkmcnt(0)" ::: "memory"); RT_BAR();
}

struct SkIn {
    bf16_t* proj; const ssq_t* ss;
    __device__ __forceinline__ void operator()(f32x4 va, f32x4 vb, int ta, int lane) const {
        const int tok = lane & 15, fq = lane >> 4, R = METAR0 + tok, kind = ta >> 7, n0 = 16 * ta + 4 * fq;
        float rstd = rstd_of(ss, R);
        if (kind < 2) rstd *= __builtin_amdgcn_exp2f((kind == 0 ? 1.0f : -1.0f) * (float)(R & 255) * head_lg((n0 >> 8) & 7));
        va *= rstd; vb *= rstd;
        if (kind < 2) {
            const float ksc = (kind == 1) ? 0.0625f : 1.0f, t = (float)tok;
#pragma unroll
            for (int r = 0; r < 4; ++r) {
                const float inv = __builtin_amdgcn_exp2f(-(float)((n0 & 255) + r) * (13.287712379549449f / 128.0f)) * 0.15915494309189535f;
                const float f = __builtin_amdgcn_fractf(t * inv), sn = __builtin_amdgcn_sinf(f), cs = __builtin_amdgcn_cosf(f);
                const float x1 = va[r], x2 = vb[r];
                va[r] = (x1 * cs - x2 * sn) * ksc; vb[r] = (x1 * sn + x2 * cs) * ksc;
            }
        } else if (kind == 3) {
#pragma unroll
            for (int r = 0; r < 4; ++r) { va[r] = silu_f(va[r]); vb[r] = silu_f(vb[r]); }
        }
        u32x2 wa, wb; wa.x = cvt_pk_bf16(va[0], va[1]); wa.y = cvt_pk_bf16(va[2], va[3]); wb.x = cvt_pk_bf16(vb[0], vb[1]); wb.y = cvt_pk_bf16(vb[2], vb[3]);
        *(u32x2*)(proj + (size_t)R * INC + n0) = wa; *(u32x2*)(proj + (size_t)R * INC + n0 + 128) = wb;
    }
};
struct SkBf {
    bf16_t* O; int ldc; const ssq_t* ss;
    __device__ __forceinline__ void operator()(f32x4 va, f32x4 vb, int ta, int lane) const {
        const int tok = lane & 15, fq = lane >> 4, R = METAR0 + tok, n0 = 16 * ta + 4 * fq;
        const float rstd = rstd_of(ss, R);
        va *= rstd; vb *= rstd;
        u32x2 wa, wb; wa.x = cvt_pk_bf16(va[0], va[1]); wa.y = cvt_pk_bf16(va[2], va[3]); wb.x = cvt_pk_bf16(vb[0], vb[1]); wb.y = cvt_pk_bf16(vb[2], vb[3]);
        *(u32x2*)(O + (size_t)R * ldc + n0) = wa; *(u32x2*)(O + (size_t)R * ldc + n0 + 128) = wb;
    }
};
struct SkRes {
    float* h; bf16_t* hb; ssq_t* ssn;
    __device__ __forceinline__ void operator()(f32x4 va, f32x4 vb, int ta, int lane) const {
        const int tok = lane & 15, fq = lane >> 4, R = METAR0 + tok, n0 = 16 * ta + 4 * fq;
        float* hp = h + (size_t)R * D + n0;
        const f32x4 a = *(const f32x4*)hp + va, b = *(const f32x4*)(hp + 128) + vb;
        *(f32x4*)hp = a; *(f32x4*)(hp + 128) = b;
        u32x2 wa, wb; wa.x = cvt_pk_bf16(a[0], a[1]); wa.y = cvt_pk_bf16(a[2], a[3]); wb.x = cvt_pk_bf16(b[0], b[1]); wb.y = cvt_pk_bf16(b[2], b[3]);
        *(u32x2*)(hb + (size_t)R * D + n0) = wa; *(u32x2*)(hb + (size_t)R * D + n0 + 128) = wb;
        float sq = (a[0] * a[0] + a[1] * a[1]) + (a[2] * a[2] + a[3] * a[3]) + (b[0] * b[0] + b[1] * b[1]) + (b[2] * b[2] + b[3] * b[3]);
        sq += shx(sq, 16); sq += shx(sq, 32);
        if (fq == 0) ssq_add(ssn, R, sq);
    }
};
struct SkUpGlu {
    bf16_t* gact; const ssq_t* ss; const float* cw; const float* cb; float* SM;
    __device__ __forceinline__ void operator()(f32x4 va, f32x4 vb, int ta, int lane) const {
        const int tok = lane & 15, fq = lane >> 4, R = METAR0 + tok, j = 128 * (ta >> 4) + 16 * (ta & 7) + 4 * fq;
        const float rstd = rstd_of(ss, R);
        const f32x4 g = va * rstd, v = vb * rstd;
        const f32x4 z = (f32x4){0.f, 0.f, 0.f, 0.f};
        const f32x4 a1 = pg8::ror16v<1>(g), a2 = pg8::ror16v<2>(g);
        const f32x4 p1 = tok >= 1 ? a1 : z, p2 = tok >= 2 ? a2 : z;
        const f32x4 ac = *(const f32x4*)(cb + j) + p2 * *(const f32x4*)(cw + j) + p1 * *(const f32x4*)(cw + DFF + j) + g * *(const f32x4*)(cw + 2 * DFF + j);
        const f32x4 o = (f32x4){silu_f(ac[0]), silu_f(ac[1]), silu_f(ac[2]), silu_f(ac[3])} * v;
        u32x2 w; w.x = cvt_pk_bf16(o[0], o[1]); w.y = cvt_pk_bf16(o[2], o[3]);
        *(u32x2*)(gact + (size_t)R * DFF + j) = w;
        if (tok >= 14) *(f32x4*)(SM + (size_t)(tok - 14) * DFF + j) = g;
    }
};
struct SkRes1 {
    const float* xsrc16; bf16_t* hb; ssq_t* ssn;
    __device__ __forceinline__ void operator()(f32x4 va, f32x4, int ta, int lane) const {
        const int tok = lane & 15, fq = lane >> 4, R = METAR0 + tok, n0 = 16 * ta + 4 * fq;
        bf16_t* bp = hb + (size_t)R * D + n0;
        f32x4 a;
        if (xsrc16) a = *(const f32x4*)(xsrc16 + (size_t)tok * D + n0); else { const u32x2 hv = *(const u32x2*)bp; a = (f32x4){bf_lo(hv.x), bf_hi(hv.x), bf_lo(hv.y), bf_hi(hv.y)}; }
        a += va;
        u32x2 wa; wa.x = cvt_pk_bf16(a[0], a[1]); wa.y = cvt_pk_bf16(a[2], a[3]);
        *(u32x2*)bp = wa;
        float sq = (a[0] * a[0] + a[1] * a[1]) + (a[2] * a[2] + a[3] * a[3]);
        sq += shx(sq, 16); sq += shx(sq, 32);
        if (fq == 0) ssq_add(ssn, R, sq);
    }
};
template <bool PAIR, class Epi, int UNR = 8>
__device__ __forceinline__ void skinny_phase(Frame& F, const bf16_t* A16, int lda, const bf16_t* Bt, int ldb, int N, int K, const Epi& E, unsigned* qctr) {
    const int tid_l = F.wave * 64 + lane_id_v();
    const int lane = tid_l & 63, w = F.wave, fr = lane & 15, fq = lane >> 4;
    const int nblk = K / 64, base = nblk / 8, rem = nblk % 8;
    const int myb = base + (w < rem ? 1 : 0), b0 = w * base + (w < rem ? w : rem);
    LAS f32x4* part = (LAS f32x4*)F.lds;
    volatile LAS unsigned* qw = (volatile LAS unsigned*)(F.lds + MISC_OFF + 64);
    const bf16_t* ap = A16 + (size_t)fr * lda + 16 * fq + 64 * b0;
    const int nitems = PAIR ? N / 32 : N / 16;
    if (tid_l == 0) qw[0] = __hip_atomic_fetch_add(qctr, 1u, __ATOMIC_RELAXED, __HIP_MEMORY_SCOPE_AGENT);
    for (int it = 0;; ++it) {
        __syncthreads();
        const int item = (int)qw[it & 1];
        if (item >= nitems) break;
        unsigned nxt = 0u;
        if (tid_l == 0) nxt = __hip_atomic_fetch_add(qctr, 1u, __ATOMIC_RELAXED, __HIP_MEMORY_SCOPE_AGENT);
        const int ta = PAIR ? 16 * (item >> 3) + (item & 7) : item;
        const bf16_t* wa = Bt + (size_t)(16 * ta + fr) * ldb + 16 * fq + 64 * b0;
        const bf16_t* wb = wa + (size_t)128 * ldb;
        f32x4 acca = (f32x4){0.f, 0.f, 0.f, 0.f}, accb = (f32x4){0.f, 0.f, 0.f, 0.f};
#pragma unroll UNR
        for (int kb = 0; kb < myb; ++kb) {
            const bf16x8 a0 = *(const bf16x8*)(ap + 64 * kb), a1 = *(const bf16x8*)(ap + 64 * kb + 8);
            const bf16x8 x0 = *(const bf16x8*)(wa + 64 * kb), x1 = *(const bf16x8*)(wa + 64 * kb + 8);
            acca = __builtin_amdgcn_mfma_f32_16x16x32_bf16(x0, a0, acca, 0, 0, 0); acca = __builtin_amdgcn_mfma_f32_16x16x32_bf16(x1, a1, acca, 0, 0, 0);
            if (PAIR) {
                const bf16x8 y0 = *(const bf16x8*)(wb + 64 * kb), y1 = *(const bf16x8*)(wb + 64 * kb + 8);
                accb = __builtin_amdgcn_mfma_f32_16x16x32_bf16(y0, a0, accb, 0, 0, 0); accb = __builtin_amdgcn_mfma_f32_16x16x32_bf16(y1, a1, accb, 0, 0, 0);
            }
        }
        part[(w * 2 + 0) * 64 + lane] = acca; if (PAIR) part[(w * 2 + 1) * 64 + lane] = accb;
        if (tid_l == 0) qw[(it + 1) & 1] = nxt;
        __syncthreads();
        if (w == 0) {
            f32x4 va = part[lane], vb = (f32x4){0.f, 0.f, 0.f, 0.f};
            if (PAIR) vb = part[64 + lane];
#pragma unroll
            for (int i = 1; i < 8; ++i) { va += part[(i * 2) * 64 + lane]; if (PAIR) vb += part[(i * 2 + 1) * 64 + lane]; }
            E(va, vb, ta, lane);
        }
    }
}

constexpr int N_PHASES = 2 + 8 * NLAYER + 1;
#ifndef MK_PER_PHASE
#define MK_PER_PHASE 0
#endif

__global__ void __launch_bounds__(NWAVES * 64, 2) hymba_fwd(Args args_k) {
    (void)args_k;
#define args (*args_ptr())
    extern __shared__ __attribute__((aligned(16))) unsigned char lds_raw[];
    Frame F;
    F.lds = (LAS unsigned char*)lds_raw;
    F.wave = __builtin_amdgcn_readfirstlane((int)threadIdx.x >> 6); F.tid = F.wave * 64 + lane_id_v(); F.lane = F.tid & 63;
    F.G = gridDim.x; { const int bx = blockIdx.x; F.vcu = (F.G % 8 == 0) ? (bx % 8) * (F.G / 8) + bx / 8 : bx; }
    unsigned char* ws = args.ws;
    unsigned* ctl = (unsigned*)(ws + WS_CTL);
    volatile LAS unsigned* MISC = (volatile LAS unsigned*)(F.lds + MISC_OFF);
    for (int u = F.tid; u < (LDS_BYTES - RING_BYTES) / 4; u += NWAVES * 64) ((LAS unsigned*)(F.lds + RING_BYTES))[u] = 0u;
    __syncthreads();
    XcdBarrier bar; bar.bar = ctl + CW_BAR; bar.x = 0; bar.st = nullptr;
    if (!MK_PER_PHASE) bar = xcd_barrier_post(ctl + CW_BAR, MISC + 8, F.wave);
#define GRID_BAR() do { if (MK_PER_PHASE) { if (F.tid == 0) __hip_atomic_store(ctl + CW_TMO, 0xBADBA0u, __ATOMIC_RELAXED, __HIP_MEMORY_SCOPE_AGENT); } else { xcd_barrier(bar, F.wave); } } while (0)
    const int lo = args.ph_lo, hi = args.ph_hi; (void)lo; (void)hi;
#if MK_PER_PHASE
#define IN(k) (lo <= (k) && (k) < hi)
#define BOTH(k) (IN(k) && IN((k) + 1))
#else
#define IN(k) true
#define BOTH(k) true
#endif

#define WSP() ((unsigned char*)args_ptr()->ws)
#define WinT ((bf16_t*)(WSP() + WS_WIN))
#define WcT ((bf16_t*)(WSP() + WS_WC))
#define WbT ((bf16_t*)(WSP() + WS_WB))
#define PoolS ((bf16_t*)(WSP() + WS_POOLS))
#define WupT ((bf16_t*)(WSP() + WS_WUP))
#define WdnT ((bf16_t*)(WSP() + WS_WDN))
#define hb ((bf16_t*)(WSP() + WS_HB))
#define proj ((bf16_t*)(WSP() + WS_PROJ))
#define cat ((bf16_t*)(WSP() + WS_CAT))
#define KV ((float*)(WSP() + WS_KV))
#define Sst ((bf16_t*)(WSP() + WS_S))
#define gact ((bf16_t*)(WSP() + WS_G))
#define ssb ((ssq_t*)((unsigned*)(WSP() + WS_CTL) + CW_SS))
#define side ((float*)(WSP() + WS_SIDE))
    const int NT = F.G * NWAVES * 64;
    const int gw = F.vcu * NWAVES + F.wave, NGW = F.G * NWAVES;
#define LAUNDERED_GT(name) const int name##_t = F.wave * 64 + lane_id_v(); const int name = F.vcu * (NWAVES * 64) + name##_t

    if (IN(0)) { p0_prologue(F, args); if (BOTH(0)) GRID_BAR(); }
    for (int l = 0; l < NLAYER; ++l) {
        const int pb = 2 + 8 * l;
        if (IN(pb + 0)) {
            pg8::Gemm g{hb, WinT + (size_t)l * INC * D, MMAIN, INC, D, D, D, 1 << 30, 0u, 1 << 30, 0u};
            pg8::StaticOrder S; S.init(MMAIN, INC, F.G, launder_s((int)blockIdx.x));
            pg8::EpiIn E{proj, ssb + (2 * l) * MP};
            {
                const bool host = (l == 0); const int xcd = launder_s((int)blockIdx.x) & 7; const int split = host ? (xcd * 6) / 8 : 0;
#pragma unroll 1
                for (int part = 0; part < 2; ++part) {
                    pg8::RangeOrder R{S, part ? split : 0, part ? (1 << 30) : split};
                    pg8::gemm_phase<pg8::EpiIn, pg8::RangeOrder, true, true>(F.lds, g, R, E, F.wave);
                    if (part == 0 && host) conv_tiles(F, args, T_IN, T_L0);
                }
            }
            { SkIn Ek{proj, ssb + (2 * l) * MP}; skinny_phase<true>(F, hb + (size_t)METAR0 * D, D, WinT + (size_t)l * INC * D, D, INC, D, Ek, ctl + CW_QCTR + 64 * (4 * l + 0)); }
            if (BOTH(pb + 0)) GRID_BAR();
        }
        if (IN(pb + 1)) {
            for (int ui = F.vcu; ui < 8 + 2 * 15 * 8 + 8; ui += F.G) {
                if (ui >= 8 + 2 * 15 * 8) { ret_unit(F, proj, Sst, cat, MMAIN, ui - (8 + 2 * 15 * 8), 1, false, 7); continue; }
                int base_row, h; float* outp;
                if (ui < 8) { h = ui; base_row = MMAIN; outp = KV + (size_t)h * DH * DH; }
                else { const int j = ui - 8, b = j / 120, n = 1 + (j % 120) / 8; h = j % 8; base_row = b * SEQ + (n - 1) * 256; outp = KV + (size_t)(8 + (b * 15 + (n - 1)) * 8 + h) * DH * DH; }
                kv_unit(F, proj, outp, base_row, h);
            }
            if (l == 0) pools_build(F, args);
            LAUNDERED_GT(gt);
            for (int i = gt; i < ((MMAIN + NMETA) / 2) * (PW / 8); i += NT) {
                const int r_ = 2 * (i / (PW / 8)), R = r_ < MMAIN ? r_ : r_ + (METAR0 - MMAIN), cg = i % (PW / 8), col = cg * 8, gi = col >> 9, t = posof(R);
                const bf16_t* pp = proj + 4 * RW + col;
                float sacc[8], sacc1[8];
                const u32x4 v0 = *(const u32x4*)(pp + (size_t)R * INC), v1 = *(const u32x4*)(pp + (size_t)(R + 1) * INC);
                const float x0[8] = {bf_lo(v0.x), bf_hi(v0.x), bf_lo(v0.y), bf_hi(v0.y), bf_lo(v0.z), bf_hi(v0.z), bf_lo(v0.w), bf_hi(v0.w)};
                const float x1[8] = {bf_lo(v1.x), bf_hi(v1.x), bf_lo(v1.y), bf_hi(v1.y), bf_lo(v1.z), bf_hi(v1.z), bf_lo(v1.w), bf_hi(v1.w)};
#pragma unroll
                for (int e = 0; e < 8; ++e) { sacc[e] = x0[e]; sacc1[e] = x1[e] + x0[e]; }
                int nd, nd1;
#define MIX_WINDOW(W) do { u32x4 v[W - 1]; _Pragma("unroll") for (int d = 1; d < W; ++d) { v[d - 1] = (u32x4){0u, 0u, 0u, 0u}; if (d <= t) v[d - 1] = *(const u32x4*)(pp + (size_t)prevrow(R, d) * INC); } \
                    _Pragma("unroll") for (int d = 1; d < W; ++d) { const float y[8] = {bf_lo(v[d - 1].x), bf_hi(v[d - 1].x), bf_lo(v[d - 1].y), bf_hi(v[d - 1].y), bf_lo(v[d - 1].z), bf_hi(v[d - 1].z), bf_lo(v[d - 1].w), bf_hi(v[d - 1].w)}; \
                        _Pragma("unroll") for (int e = 0; e < 8; ++e) { sacc[e] += y[e]; if (d < W - 1) sacc1[e] += y[e]; } } \
                    nd = (W - 1) < t ? (W - 1) : t; nd1 = (W - 1) < t + 1 ? (W - 1) : t + 1; } while (0)
                if (gi == 0) MIX_WINDOW(2); else if (gi == 1) MIX_WINDOW(4); else if (gi == 2) MIX_WINDOW(8); else MIX_WINDOW(16);
#undef MIX_WINDOW
                const float ic = 1.0f / (float)(nd + 1), ic1 = 1.0f / (float)(nd1 + 1);
                u32x4 o; o.x = cvt_pk_bf16(sacc[0] * ic - x0[0], sacc[1] * ic - x0[1]); o.y = cvt_pk_bf16(sacc[2] * ic - x0[2], sacc[3] * ic - x0[3]); o.z = cvt_pk_bf16(sacc[4] * ic - x0[4], sacc[5] * ic - x0[5]); o.w = cvt_pk_bf16(sacc[6] * ic - x0[6], sacc[7] * ic - x0[7]);
                u32x4 o1; o1.x = cvt_pk_bf16(sacc1[0] * ic1 - x1[0], sacc1[1] * ic1 - x1[1]); o1.y = cvt_pk_bf16(sacc1[2] * ic1 - x1[2], sacc1[3] * ic1 - x1[3]); o1.z = cvt_pk_bf16(sacc1[4] * ic1 - x1[4], sacc1[5] * ic1 - x1[5]); o1.w = cvt_pk_bf16(sacc1[6] * ic1 - x1[6], sacc1[7] * ic1 - x1[7]);
                *(u32x4*)(cat + (size_t)R * D + RW + col) = o;
                *(u32x4*)(cat + (size_t)(R + 1) * D + RW + col) = o1;
            }
            if (BOTH(pb + 1)) GRID_BAR();
        }
        if (IN(pb + 2)) {
            LAUNDERED_GT(gt);
            for (int i = gt; i < NB * NH * (DH * DH / 8); i += NT) {
                const int b = i / (NH * 8192), h = (i / 8192) % NH, off = (i % 8192) * 8;
                const float cd = __builtin_amdgcn_exp2f(256.0f * head_lg(h));
                const float* k0 = KV + (size_t)h * DH * DH + off;
                f32x4 s0 = *(const f32x4*)k0, s1 = *(const f32x4*)(k0 + 4);
                bf16_t* sp = Sst + ((size_t)(b * NCHK) * NH + h) * DH * DH + off;
                f32x4 av[NCHK - 1][2];
#pragma unroll
                for (int n = 1; n < NCHK; ++n) { const float* kp = KV + (size_t)(8 + (b * 15 + (n - 1)) * 8 + h) * DH * DH + off; av[n - 1][0] = *(const f32x4*)kp; av[n - 1][1] = *(const f32x4*)(kp + 4); }
                asm volatile("" : "+v"(av[0][0]), "+v"(av[0][1]), "+v"(av[1][0]), "+v"(av[1][1]), "+v"(av[2][0]), "+v"(av[2][1]), "+v"(av[3][0]), "+v"(av[3][1]), "+v"(av[4][0]), "+v"(av[4][1]), "+v"(av[5][0]), "+v"(av[5][1]), "+v"(av[6][0]), "+v"(av[6][1]), "+v"(av[7][0]));
                asm volatile("" : "+v"(av[7][1]), "+v"(av[8][0]), "+v"(av[8][1]), "+v"(av[9][0]), "+v"(av[9][1]), "+v"(av[10][0]), "+v"(av[10][1]), "+v"(av[11][0]), "+v"(av[11][1]), "+v"(av[12][0]), "+v"(av[12][1]), "+v"(av[13][0]), "+v"(av[13][1]), "+v"(av[14][0]), "+v"(av[14][1]));
                { u32x4 o; o.x = cvt_pk_bf16(s0[0], s0[1]); o.y = cvt_pk_bf16(s0[2], s0[3]); o.z = cvt_pk_bf16(s1[0], s1[1]); o.w = cvt_pk_bf16(s1[2], s1[3]); *(u32x4*)sp = o; }
#pragma unroll
                for (int n = 1; n < NCHK; ++n) {
                    const f32x4 a0 = av[n - 1][0], a1 = av[n - 1][1];
                    s0 = s0 * cd + a0; s1 = s1 * cd + a1;
                    u32x4 o; o.x = cvt_pk_bf16(s0[0], s0[1]); o.y = cvt_pk_bf16(s0[2], s0[3]); o.z = cvt_pk_bf16(s1[0], s1[1]); o.w = cvt_pk_bf16(s1[2], s1[3]);
                    *(u32x4*)(sp + (size_t)n * NH * DH * DH) = o;
                }
            }
            if (l == 0) {
                pg8::Gemm g{WbT, PoolS, NLAYER * D, PW, 512, PW, 512, 2, 1024u, 16, (unsigned)(2048 * 512 * 2)};
                pg8::StaticOrder S; S.init(NLAYER * D, PW, F.G, launder_s((int)blockIdx.x));
                pg8::EpiBf E{WcT, D, RW, nullptr};
                pg8::gemm_phase<pg8::EpiBf, pg8::StaticOrder, true, true>(F.lds, g, S, E, F.wave);
            }
            if (BOTH(pb + 2)) GRID_BAR();
        }
        if (IN(pb + 3)) {
            for (int ui = F.vcu; ui < 512; ui += F.G) {
                { const int b = ui >> 8, half = (ui & 1) ^ b, h = (ui >> 1) & 7, n = 1 + ((ui >> 4) & 15);
                    ret_unit(F, proj, Sst + ((size_t)(b * NCHK + (n - 1)) * NH + h) * DH * DH, cat, b * SEQ + (n - 1) * 256, h, half, true, 0); }
            }
            if (BOTH(pb + 3)) GRID_BAR();
        }
        if (IN(pb + 4)) {
            pg8::Gemm g{cat, WcT + (size_t)l * D * D, MMAIN, D, D, D, D, 1 << 30, 0u, 1 << 30, 0u};
            pg8::StaticOrder S; S.init(MMAIN, D, F.G, launder_s((int)blockIdx.x));
            pg8::EpiRes E{l == 0 ? args.x : nullptr, hb, ssb + (2 * l + 1) * MP, 1.0f};
            pg8::gemm_phase<pg8::EpiRes, pg8::StaticOrder, true, true>(F.lds, g, S, E, F.wave);
            { SkRes1 Ek{l == 0 ? args.meta : nullptr, hb, ssb + (2 * l + 1) * MP}; skinny_phase<false>(F, cat + (size_t)METAR0 * D, D, WcT + (size_t)l * D * D, D, D, D, Ek, ctl + CW_QCTR + 64 * (4 * l + 1)); }
            if (BOTH(pb + 4)) GRID_BAR();
        }
        if (IN(pb + 5)) {
            pg8::Gemm g{hb, WupT + (size_t)l * UPC * D, MMAIN, UPC, D, D, D, 1 << 30, 0u, 1 << 30, 0u};
            pg8::StaticOrder S; S.init(MMAIN, UPC, F.G, launder_s((int)blockIdx.x));
            const float* cw = args.conv_w + (size_t)l * 3 * DFF; const float* cbp = args.conv_b + (size_t)l * DFF;
            pg8::EpiUpGlu E{gact, ssb + (2 * l + 1) * MP, cw, cbp, side, F.lds + XCH_OFF, l == NLAYER - 1 ? 1 : 2};
            {
                const bool host = (l == 0); const int xcd = launder_s((int)blockIdx.x) & 7; const int split = host ? (xcd * 12) / 8 : 0;
#pragma unroll 1
                for (int part = 0; part < 2; ++part) {
                    pg8::RangeOrder R{S, part ? split : 0, part ? (1 << 30) : split};
                    pg8::gemm_phase<pg8::EpiUpGlu, pg8::RangeOrder, true, true>(F.lds, g, R, E, F.wave);
                    if (part == 0 && host) conv_tiles(F, args, T_L0, T_ALL);
                }
            }
            { SkUpGlu Ek{gact, ssb + (2 * l + 1) * MP, cw, cbp, side + 3 * (32 * 2 * DFF)}; skinny_phase<true>(F, hb + (size_t)METAR0 * D, D, WupT + (size_t)l * UPC * D, D, UPC, D, Ek, ctl + CW_QCTR + 64 * (4 * l + 2)); }
            if (BOTH(pb + 5)) GRID_BAR();
        }
        if (IN(pb + 6)) {
            const float* cw = args.conv_w + (size_t)l * 3 * DFF; const float* cbp = args.conv_b + (size_t)l * DFF;
            const float* SA = side; const float* SB = side + 32 * 2 * DFF; const float* SL = side + 2 * (32 * 2 * DFF); const float* SM = side + 3 * (32 * 2 * DFF);
            LAUNDERED_GT(gt);
            for (int i = gt; i < 64 * (DFF / 4); i += NT) {
                const int pr = i / (DFF / 4), j = (i % (DFF / 4)) * 4, pm = pr >> 1, r = pr & 1;
                const bool first = (pm & 15) == 0;
                const float* l0 = first ? SM : SL + (size_t)((pm - 1) * 2) * DFF;
                const float* l1 = l0 + DFF;
                const f32x4 a0 = *(const f32x4*)(SA + (size_t)(pm * 2 + r) * DFF + j), bv = *(const f32x4*)(SB + (size_t)(pm * 2 + r) * DFF + j);
                const f32x4 a1 = r ? *(const f32x4*)(SA + (size_t)(pm * 2) * DFF + j) : *(const f32x4*)(l1 + j);
                const f32x4 a2 = r ? *(const f32x4*)(l1 + j) : *(const f32x4*)(l0 + j);
                const f32x4 ac = *(const f32x4*)(cbp + j) + a2 * *(const f32x4*)(cw + j) + a1 * *(const f32x4*)(cw + DFF + j) + a0 * *(const f32x4*)(cw + 2 * DFF + j);
                const f32x4 o = (f32x4){silu_f(ac[0]), silu_f(ac[1]), silu_f(ac[2]), silu_f(ac[3])} * bv;
                u32x2 w; w.x = cvt_pk_bf16(o[0], o[1]); w.y = cvt_pk_bf16(o[2], o[3]);
                if (l == NLAYER - 1) *(unsigned*)((unsigned char*)gact + (size_t)(pm * 256 + r) * DFF + j) = pk4_fp8(o[0], o[1], o[2], o[3]);
                else if (j >= K1MIX) *(unsigned*)((unsigned char*)gact + (size_t)(pm * 256 + r) * (2 * DFF) + K1MIX + j) = pk4_fp8(o[0], o[1], o[2], o[3]);
                else *(u32x2*)(gact + (size_t)(pm * 256 + r) * DFF + j) = w;
            }
            if (BOTH(pb + 6)) GRID_BAR();
        }
        if (IN(pb + 7)) {
            pg8::StaticOrder S; S.init(MMAIN, D, F.G, launder_s((int)blockIdx.x));
            if (l == NLAYER - 1) {
                pg8::Gemm g{gact, (const bf16_t*)(ws + WS_WDN8), MMAIN, D, DFF / 2, DFF / 2, DFF / 2, 1 << 30, 0u, 1 << 30, 0u};
                pg8::PanelOrder SP; SP.init(F.G, launder_s((int)blockIdx.x));
                pg8::EpiFinal E{hb, ssb + (2 * l + 2) * MP, W8_INV, ctl + CW_PCNT, args.final_g, args.out};
                pg8::gemm_phase<pg8::EpiFinal, pg8::PanelOrder, true, true, true>(F.lds, g, SP, E, F.wave);
            } else {
                pg8::Gemm g{gact, WdnT + (size_t)l * D * DFF, MMAIN, D, K1MIX, DFF, DFF, 1 << 30, 0u, 1 << 30, 0u};
                pg8::EpiRes E{nullptr, hb, ssb + (2 * l + 2) * MP, 1.0f};
                pg8::gemm_phase_mix<pg8::EpiRes, pg8::StaticOrder>(F.lds, g, (const char*)gact + 2 * K1MIX, (const char*)(ws + WS_WDN8L0) + K1MIX, (DFF - K1MIX) / 128, S, E, F.wave);
            }
            if (l + 1 < NLAYER) { SkRes1 Ek{nullptr, hb, ssb + (2 * l + 2) * MP}; skinny_phase<false, SkRes1, 11>(
                F, gact + (size_t)METAR0 * DFF, DFF, WdnT + (size_t)l * D * DFF, DFF, D, DFF, Ek, ctl + CW_QCTR + 64 * (4 * l + 3)); }
            if (BOTH(pb + 7) && l + 1 < NLAYER) GRID_BAR();
        }
    }
#undef IN
#undef BOTH
#undef GRID_BAR
}

extern "C" void kernel_launch(void* const* d_in, const int* in_sizes, int n_in, void* d_out, int out_size, void* d_ws, size_t ws_size, hipStream_t stream) {
    static int grid = 0;
    if (grid == 0) {
        if (n_in != 13 || in_sizes[0] != MMAIN * D || out_size != MMAIN * D || ws_size < WS_END) { fprintf(stderr, "kernel_launch: unexpected shapes (n_in %d, in0 %d, out %d, ws %zu, need %zu)\n", n_in, n_in > 0 ? in_sizes[0] : -1, out_size, ws_size, (size_t)WS_END); grid = -1; return; }
        int dev = 0, cus = 0, per_cu = 0;
        if (hipGetDevice(&dev) != hipSuccess || hipDeviceGetAttribute(&cus, hipDeviceAttributeMultiprocessorCount, dev) != hipSuccess) { fprintf(stderr, "kernel_launch: device query failed\n"); grid = -1; return; }
        if (hipFuncSetAttribute((const void*)hymba_fwd, hipFuncAttributeMaxDynamicSharedMemorySize, LDS_BYTES) != hipSuccess) { fprintf(stderr, "kernel_launch: hipFuncSetAttribute failed\n"); grid = -1; return; }
        if (hipOccupancyMaxActiveBlocksPerMultiprocessor(&per_cu, (const void*)hymba_fwd, NWAVES * 64, LDS_BYTES) != hipSuccess || per_cu < 1)
            fprintf(stderr, "kernel_launch: note: occupancy query reports %d workgroups per CU\n", per_cu);
        (void)hipGetLastError();
        grid = cus;
    }
    if (grid < 0) return;
    if (hipMemsetAsync((char*)d_ws + WS_CTL, 0, CTL_ZERO_BYTES, stream) != hipSuccess) { fprintf(stderr, "kernel_launch: memset failed\n"); return; }
    if (hipMemsetAsync((char*)d_ws + WS_PROJ + (size_t)MMAIN * INC * 2, 0, (size_t)(METAR0 - MMAIN) * INC * 2, stream) != hipSuccess) { fprintf(stderr, "kernel_launch: memset failed\n"); return; }
    Args a{};
    a.x = (const float*)d_in[0]; a.meta = (const float*)d_in[1]; a.n1g = (const float*)d_in[2]; a.w_in = (const float*)d_in[3]; a.pool_w = (const float*)d_in[4]; a.pool_scale = (const float*)d_in[5];
    a.w_out = (const float*)d_in[6]; a.n2g = (const float*)d_in[7]; a.w_up = (const float*)d_in[8]; a.conv_w = (const float*)d_in[9]; a.conv_b = (const float*)d_in[10]; a.w_down = (const float*)d_in[11]; a.final_g = (const float*)d_in[12];
    a.out = (float*)d_out; a.ws = (unsigned char*)d_ws;
#if MK_PER_PHASE
    for (int p = 0; p < N_PHASES; ++p) { a.ph_lo = p; a.ph_hi = p + 1; hipLaunchKernelGGL(hymba_fwd, dim3(grid), dim3(NWAVES * 64), LDS_BYTES, stream, a); }
#else
    a.ph_lo = 0; a.ph_hi = N_PHASES;
    hipLaunchKernelGGL(hymba_fwd, dim3(grid), dim3(NWAVES * 64), LDS_BYTES, stream, a);
#endif
    const hipError_t le = hipPeekAtLastError();
    if (le != hipSuccess) fprintf(stderr, "kernel_launch: launch failed: %s\n", hipGetErrorName(le));
}
```
